# Optimizing an MI355X kernel written in HIP

```python
import math
import jax, jax.numpy as jnp
from jax import lax
import numpy as np

D_MODEL = 1024
BATCH = 8
SEQ = 4096
DEPTH = 2

CHUNK = 64
PLE_DIM = 256
LRU_WIDTH = 1280
LRU_HEADS = 10
LRU_HEAD_DIM = LRU_WIDTH // LRU_HEADS
LRU_CONV = 4
LRU_C = 8.0
S5_WIDTH = D_MODEL
S5_GROUP = 16
S5_GROUPS = S5_WIDTH // S5_GROUP
S5_STATE = 64
D_FF = 3 * D_MODEL
FFN_CONV = 3
IN_COLS = 2 * LRU_WIDTH + S5_WIDTH + 2 * D_MODEL
EPS = 1e-6

kernel_name = "griffin_s5_convffn_hybrid"


def rmsnorm(x, g):
    xf = x.astype(jnp.float32)
    y = xf * lax.rsqrt(jnp.mean(xf * xf, axis=-1, keepdims=True) + EPS)
    return (y * g.astype(jnp.float32)).astype(x.dtype)


def causal_dwconv(x, w, b):
    k = w.shape[0]
    s = x.shape[1]
    xp = jnp.pad(x, ((0, 0), (k - 1, 0), (0, 0)))
    y = b
    for j in range(k):
        y = y + xp[:, j:j + s] * w[j]
    return y


def rglru_branch(xa, gate_br, conv_w, conv_b, gx_w, gx_b, ga_w, ga_b, lam):
    xc = causal_dwconv(xa, conv_w, conv_b)
    bsz, s, _ = xc.shape
    xh = xc.reshape(bsz, s, LRU_HEADS, LRU_HEAD_DIM)
    gx = jax.nn.sigmoid(jnp.einsum('bshi,hij->bshj', xh, gx_w).reshape(bsz, s, LRU_WIDTH) + gx_b)
    ga = jax.nn.sigmoid(jnp.einsum('bshi,hij->bshj', xh, ga_w).reshape(bsz, s, LRU_WIDTH) + ga_b)
    log_a = (LRU_C * ga.astype(jnp.float32)) * jax.nn.log_sigmoid(lam.astype(jnp.float32))
    a = jnp.exp(log_a)
    mult = jnp.sqrt(jnp.maximum(-jnp.expm1(2.0 * log_a), 1e-12))
    u = mult * (gx * xc).astype(jnp.float32)

    def combine(e1, e2):
        return (e1[0] * e2[0], e2[0] * e1[1] + e2[1])

    _, h = lax.associative_scan(combine, (a, u), axis=1)
    return h.astype(xa.dtype) * jax.nn.gelu(gate_br)


def s5_ssm(u, a_re, a_im, log_dt, b_re, b_im, c_re, c_im, d):
    f32 = jnp.float32
    a_re = a_re.astype(f32); a_im = a_im.astype(f32)
    b_re = b_re.astype(f32); b_im = b_im.astype(f32)
    c_re = c_re.astype(f32); c_im = c_im.astype(f32)
    dt = jnp.exp(log_dt.astype(f32))[:, None]
    mag = jnp.exp(a_re * dt)
    lb_re = mag * jnp.cos(a_im * dt)
    lb_im = mag * jnp.sin(a_im * dt)
    nr = lb_re - 1.0
    ni = lb_im
    den = a_re * a_re + a_im * a_im
    coef_re = (nr * a_re + ni * a_im) / den
    coef_im = (ni * a_re - nr * a_im) / den
    bb_re = coef_re[..., None] * b_re - coef_im[..., None] * b_im
    bb_im = coef_re[..., None] * b_im + coef_im[..., None] * b_re

    bsz, s, _ = u.shape
    nc = s // CHUNK
    uc = u.astype(f32).reshape(bsz, nc, CHUNK, S5_GROUPS, S5_GROUP).transpose(1, 2, 0, 3, 4)
    a_el_re = jnp.broadcast_to(lb_re, (CHUNK, 1, S5_GROUPS, S5_STATE))
    a_el_im = jnp.broadcast_to(lb_im, (CHUNK, 1, S5_GROUPS, S5_STATE))

    def combine(e1, e2):
        a1r, a1i, b1r, b1i = e1
        a2r, a2i, b2r, b2i = e2
        return (a2r * a1r - a2i * a1i,
                a2r * a1i + a2i * a1r,
                a2r * b1r - a2i * b1i + b2r,
                a2r * b1i + a2i * b1r + b2i)

    def step(carry, u_blk):
        c_r, c_i = carry
        bu_re = jnp.einsum('lbgc,gpc->lbgp', u_blk, bb_re)
        bu_im = jnp.einsum('lbgc,gpc->lbgp', u_blk, bb_im)
        ar, ai, sr, si = lax.associative_scan(combine, (a_el_re, a_el_im, bu_re, bu_im), axis=0)
        x_re = sr + ar * c_r[None] - ai * c_i[None]
        x_im = si + ar * c_i[None] + ai * c_r[None]
        y = jnp.einsum('lbgp,gcp->lbgc', x_re, c_re) - jnp.einsum('lbgp,gcp->lbgc', x_im, c_im)
        return (x_re[-1], x_im[-1]), y

    init = (jnp.zeros((bsz, S5_GROUPS, S5_STATE), f32), jnp.zeros((bsz, S5_GROUPS, S5_STATE), f32))
    _, y = lax.scan(step, init, uc)
    y = y.transpose(2, 0, 1, 3, 4).reshape(bsz, s, S5_WIDTH)
    return (y + d.astype(f32) * u.astype(f32)).astype(u.dtype)


def setup_inputs(seed: int = 0) -> dict:
    key = jax.random.key(seed)
    ks = jax.random.split(key, 40)
    nrm = lambda k, shape, scale: jax.random.normal(k, shape, jnp.float32) * scale
    x = jax.random.normal(ks[0], (BATCH, SEQ, D_MODEL), jnp.float32)
    p = jax.random.normal(ks[1], (DEPTH, BATCH, SEQ, PLE_DIM), jnp.float32)
    g_mix = 1.0 + nrm(ks[2], (DEPTH, D_MODEL), 0.02)
    w_in = nrm(ks[3], (DEPTH, D_MODEL, IN_COLS), D_MODEL ** -0.5)
    conv_a_w = nrm(ks[4], (DEPTH, LRU_CONV, LRU_WIDTH), LRU_CONV ** -0.5)
    conv_a_b = nrm(ks[5], (DEPTH, LRU_WIDTH), 0.01)
    gate_x_w = nrm(ks[6], (DEPTH, LRU_HEADS, LRU_HEAD_DIM, LRU_HEAD_DIM), LRU_HEAD_DIM ** -0.5)
    gate_x_b = nrm(ks[7], (DEPTH, LRU_WIDTH), 0.01)
    gate_a_w = nrm(ks[8], (DEPTH, LRU_HEADS, LRU_HEAD_DIM, LRU_HEAD_DIM), LRU_HEAD_DIM ** -0.5)
    gate_a_b = nrm(ks[9], (DEPTH, LRU_WIDTH), 0.01)
    a_target = jax.random.uniform(ks[10], (DEPTH, LRU_WIDTH), jnp.float32, 0.9, 0.999)
    a0 = a_target ** (1.0 / LRU_C)
    lru_lambda = jnp.log(a0) - jnp.log1p(-a0)
    w_a_out = nrm(ks[11], (DEPTH, LRU_WIDTH, D_MODEL), LRU_WIDTH ** -0.5)
    s5_a_re = -0.5 + nrm(ks[12], (DEPTH, S5_GROUPS, S5_STATE), 0.01)
    s5_a_im = jnp.pi * jnp.arange(S5_STATE, dtype=jnp.float32) + nrm(ks[13], (DEPTH, S5_GROUPS, S5_STATE), 0.01)
    s5_log_dt = jax.random.uniform(ks[14], (DEPTH, S5_GROUPS), jnp.float32, math.log(1e-3), math.log(1e-1))
    s5_b_re = nrm(ks[15], (DEPTH, S5_GROUPS, S5_STATE, S5_GROUP), (2 * S5_GROUP) ** -0.5)
    s5_b_im = nrm(ks[16], (DEPTH, S5_GROUPS, S5_STATE, S5_GROUP), (2 * S5_GROUP) ** -0.5)
    s5_c_re = nrm(ks[17], (DEPTH, S5_GROUPS, S5_GROUP, S5_STATE), (2 * S5_STATE) ** -0.5)
    s5_c_im = nrm(ks[18], (DEPTH, S5_GROUPS, S5_GROUP, S5_STATE), (2 * S5_STATE) ** -0.5)
    s5_d = nrm(ks[19], (DEPTH, S5_WIDTH), 1.0)
    w_glu = nrm(ks[20], (DEPTH, S5_WIDTH, 2 * D_MODEL), S5_WIDTH ** -0.5)
    b_glu = nrm(ks[21], (DEPTH, 2 * D_MODEL), 0.01)
    w_o = nrm(ks[22], (DEPTH, D_MODEL, D_MODEL), D_MODEL ** -0.5)
    g_ffn = 1.0 + nrm(ks[23], (DEPTH, D_MODEL), 0.02)
    w_up = nrm(ks[24], (DEPTH, D_MODEL, 2 * D_FF), D_MODEL ** -0.5)
    conv_f_w = nrm(ks[25], (DEPTH, FFN_CONV, 2 * D_FF), FFN_CONV ** -0.5)
    conv_f_b = nrm(ks[26], (DEPTH, 2 * D_FF), 0.01)
    w_down = nrm(ks[27], (DEPTH, D_FF, D_MODEL), D_FF ** -0.5)
    g_ple = 1.0 + nrm(ks[28], (DEPTH, D_MODEL), 0.02)
    w_ple_gate = nrm(ks[29], (DEPTH, D_MODEL, D_MODEL), D_MODEL ** -0.5)
    w_ple_proj = nrm(ks[30], (DEPTH, PLE_DIM, D_MODEL), PLE_DIM ** -0.5)
    g_final = 1.0 + nrm(ks[31], (D_MODEL,), 0.02)
    return {"x": x, "p": p, "g_mix": g_mix, "w_in": w_in, "conv_a_w": conv_a_w, "conv_a_b": conv_a_b,
            "gate_x_w": gate_x_w, "gate_x_b": gate_x_b, "gate_a_w": gate_a_w, "gate_a_b": gate_a_b,
            "lru_lambda": lru_lambda, "w_a_out": w_a_out, "s5_a_re": s5_a_re, "s5_a_im": s5_a_im,
            "s5_log_dt": s5_log_dt, "s5_b_re": s5_b_re, "s5_b_im": s5_b_im, "s5_c_re": s5_c_re,
            "s5_c_im": s5_c_im, "s5_d": s5_d, "w_glu": w_glu, "b_glu": b_glu, "w_o": w_o,
            "g_ffn": g_ffn, "w_up": w_up, "conv_f_w": conv_f_w, "conv_f_b": conv_f_b, "w_down": w_down,
            "g_ple": g_ple, "w_ple_gate": w_ple_gate, "w_ple_proj": w_ple_proj, "g_final": g_final}


def reference(x, p, g_mix, w_in, conv_a_w, conv_a_b, gate_x_w, gate_x_b, gate_a_w, gate_a_b,
              lru_lambda, w_a_out, s5_a_re, s5_a_im, s5_log_dt, s5_b_re, s5_b_im, s5_c_re,
              s5_c_im, s5_d, w_glu, b_glu, w_o, g_ffn, w_up, conv_f_w, conv_f_b, w_down,
              g_ple, w_ple_gate, w_ple_proj, g_final):
    o1 = LRU_WIDTH
    o2 = 2 * LRU_WIDTH
    o3 = o2 + S5_WIDTH
    o4 = o3 + D_MODEL
    for i in range(DEPTH):
        h = rmsnorm(x, g_mix[i])
        z = h @ w_in[i]
        xa, gate_br, ub = z[..., :o1], z[..., o1:o2], z[..., o2:o3]
        m_a, m_b = z[..., o3:o4], z[..., o4:]
        ya = rglru_branch(xa, gate_br, conv_a_w[i], conv_a_b[i], gate_x_w[i], gate_x_b[i],
                          gate_a_w[i], gate_a_b[i], lru_lambda[i]) @ w_a_out[i]
        ys = jax.nn.gelu(s5_ssm(ub, s5_a_re[i], s5_a_im[i], s5_log_dt[i], s5_b_re[i], s5_b_im[i],
                                s5_c_re[i], s5_c_im[i], s5_d[i]))
        glu = ys @ w_glu[i] + b_glu[i]
        yb = glu[..., :D_MODEL] * jax.nn.sigmoid(glu[..., D_MODEL:])
        merged = jax.nn.sigmoid(m_a) * ya + jax.nn.sigmoid(m_b) * yb
        x = x + merged @ w_o[i]
        h = rmsnorm(x, g_ffn[i])
        up = causal_dwconv(h @ w_up[i], conv_f_w[i], conv_f_b[i])
        x = x + (jax.nn.gelu(up[..., :D_FF]) * up[..., D_FF:]) @ w_down[i]
        gate = jax.nn.sigmoid(rmsnorm(x, g_ple[i]) @ w_ple_gate[i])
        x = x + gate * (p[i] @ w_ple_proj[i])
    return rmsnorm(x, g_final)
```

```cpp
#include <hip/hip_runtime.h>
#include <hip/hip_cooperative_groups.h>
#include <cstdio>
#include <cstdint>
namespace cg = cooperative_groups;

#define LAS __attribute__((address_space(3)))
typedef unsigned short bf16_t;
typedef short bf16x8 __attribute__((ext_vector_type(8)));
typedef float f32x4 __attribute__((ext_vector_type(4)));
typedef float f32x2 __attribute__((ext_vector_type(2)));
typedef unsigned u32x4 __attribute__((ext_vector_type(4)));
typedef unsigned u32x2 __attribute__((ext_vector_type(2)));
typedef _Float16 h16x2 __attribute__((ext_vector_type(2)));

constexpr int M = 32768, SEQ = 4096, D = 1024, LW = 1280, NIN = 5632, DFF = 3072, PLE = 256, DEPTH = 2;
constexpr float EPS = 1e-6f;
constexpr int A2LD = 24576;
constexpr int NTHREADS = 512, NWAVES = 8;
constexpr int LDS_BYTES = 131072 + 8192;

constexpr size_t MiB = 1u << 20;
constexpr size_t WS_SS = 502 * MiB;
constexpr size_t WS_C8 = 0;
constexpr size_t WS_KD = 1 * MiB;
constexpr size_t WS_SUM = 2 * MiB;
constexpr size_t WS_BAR = 7 * MiB;
constexpr size_t WS_W = 8 * MiB;
constexpr size_t WS_XB = 70 * MiB;
constexpr size_t WS_R1 = 134 * MiB;
constexpr size_t WS_R2 = 214 * MiB;
constexpr size_t WS_A2 = 294 * MiB;
constexpr size_t WS_R3 = 390 * MiB;
constexpr size_t WS_H = 134 * MiB;
constexpr size_t WS_HB = 326 * MiB;
constexpr size_t WS_PP = 422 * MiB;
constexpr size_t WS_HB4 = 470 * MiB;
constexpr size_t WS_PB = 486 * MiB;
constexpr size_t W_IN = 0;
constexpr size_t W_MG = W_IN + (size_t)3584 * 1024;
constexpr size_t W_GATE = W_MG + (size_t)2048 * 1024;
constexpr size_t W_AO = W_GATE + (size_t)2560 * 256;
constexpr size_t W_GLU = W_AO + (size_t)1024 * 1280;
constexpr size_t W_O = W_GLU + (size_t)2048 * 1024;
constexpr size_t W_UP = W_O + (size_t)1024 * 1024;
constexpr size_t W_DN = W_UP + (size_t)6144 * 1024;
constexpr size_t W_PG = W_DN + (size_t)1024 * 3072;
constexpr size_t W_PP = W_PG + (size_t)1024 * 1024;
constexpr size_t W_T1 = W_PP + (size_t)1024 * 256;
constexpr size_t W_T2 = W_T1 + (size_t)64 * 256 * 256;
constexpr size_t W_END = W_T2 + (size_t)64 * 256 * 384;
static_assert(W_END * 2 <= 62 * MiB, "weight region");

__device__ __forceinline__ unsigned pk_bf(float lo, float hi) { unsigned r; asm volatile("v_cvt_pk_bf16_f32 %0, %1, %2" : "=v"(r) : "v"(lo), "v"(hi)); return r; }
__device__ __forceinline__ bf16_t f2bf(float f) { return (bf16_t)(pk_bf(f, 0.f) & 0xffffu); }
__device__ __forceinline__ float bf2f(bf16_t b) { return __uint_as_float(((unsigned)b) << 16); }
__device__ __forceinline__ float lo_bf(unsigned w) { return __uint_as_float(w << 16); }
__device__ __forceinline__ float hi_bf(unsigned w) { return __uint_as_float(w & 0xffff0000u); }
__device__ __forceinline__ float sigmoidf_(float x) { return __builtin_amdgcn_rcpf(1.0f + __builtin_amdgcn_exp2f(-1.44269504f * x)); }
__device__ __forceinline__ float gelu_t(float x) { const float t = x * x; return x * __builtin_amdgcn_rcpf(1.0f + __builtin_amdgcn_exp2f(x * (-2.3022082f - 0.1029432f * t))); }
__device__ __forceinline__ void unpack8(const u32x4 w, float (&v)[8]) { v[0] = lo_bf(w.x); v[1] = hi_bf(w.x); v[2] = lo_bf(w.y); v[3] = hi_bf(w.y); v[4] = lo_bf(w.z); v[5] = hi_bf(w.z); v[6] = lo_bf(w.w); v[7] = hi_bf(w.w); }
__device__ __forceinline__ u32x4 pack8(const float (&v)[8]) { u32x4 w; w.x = pk_bf(v[0], v[1]); w.y = pk_bf(v[2], v[3]); w.z = pk_bf(v[4], v[5]); w.w = pk_bf(v[6], v[7]); return w; }
__device__ __forceinline__ unsigned pk_h(float a, float b) { h16x2 h; h.x = (_Float16)a; h.y = (_Float16)b; return __builtin_bit_cast(unsigned, h); }
typedef unsigned long long ss_t;
__device__ __forceinline__ float rstd_of(ss_t v) { return rsqrtf((float)v * (1.0f / 16777216.0f) * (1.0f / D) + EPS); }
__device__ __forceinline__ ss_t ss_fix(float q) { return (ss_t)(q * 16777216.0f); }
__device__ __forceinline__ float wave_sum(float v) {
#pragma unroll
    for (int o = 32; o >= 1; o >>= 1) v += __shfl_xor(v, o);
    return v;
}

__device__ __forceinline__ int bidx() { int b = blockIdx.x; asm volatile("" : "+s"(b)); return b; }
__device__ __forceinline__ int gdim() { int g = gridDim.x; asm volatile("" : "+s"(g)); return g; }
constexpr int BM = 256, BK = 64, HALF = 128, HTB = HALF * BK * 2, STAGE_BYTES = 8 * HTB, NXCD = 8, WGM = 8;
__device__ __forceinline__ int lds_byte(int r, int c) { const int st = (r >> 4) * 2 + (c >> 5), rr = r & 15, cc = c & 31, ob = rr * 64 + cc * 2; return st * 1024 + (ob ^ (((ob >> 9) & 1) << 5)); }
__device__ __forceinline__ void stage_rc(int b, int& R, int& C) { const int st = b / 1024, sb = b % 1024, swz = sb ^ (((sb >> 9) & 1) << 5); R = (st >> 1) * 16 + swz / 64; C = (st & 1) * 32 + (swz % 64) / 2; }
__device__ __forceinline__ int perm32(int rho) { const int n = rho >> 4, i = rho & 15; return 8 * (i >> 2) + 4 * n + (i & 3); }

struct Unit { int pm, pn; };
struct Gemm {
    const bf16_t* A; const bf16_t* Bt; int K;
    int lda, ldb, a_packed;
    long a_tstep, a_hstep, a_kstep;
    long b_tstep, b_hstep;
    long a_pn_bytes; int a_pn_shift;
    int nM, nN;
};
__device__ __forceinline__ Gemm mk_gemm(const bf16_t* A, int lda, const bf16_t* Bt, int K, int nM, int nN) {
    Gemm g; g.A = A; g.Bt = Bt; g.K = K; g.lda = lda; g.ldb = K; g.a_packed = 0;
    g.a_tstep = (long)256 * lda * 2; g.a_hstep = (long)128 * lda * 2; g.a_kstep = 128;
    g.b_tstep = (long)256 * K * 2; g.b_hstep = (long)128 * K * 2; g.a_pn_bytes = 0; g.a_pn_shift = 0; g.nM = nM; g.nN = nN; return g;
}
struct StaticOrder {
    int nM, nN, nwg, G, c;
    __device__ void init(int nM_, int nN_, int G_, int c_) { nM = nM_; nN = nN_; nwg = nM * nN; G = G_; c = c_; }
    __device__ bool next(int i, Unit& u) const {
        const long L = (long)i * G + c; if (L >= nwg) return false;
        int wgid = (int)L; { const int q = nwg / NXCD, r = nwg % NXCD, xcd = wgid % NXCD, off = wgid / NXCD; wgid = (xcd < r ? xcd * (q + 1) : r * (q + 1) + (xcd - r) * q) + off; }
        const int nig = WGM * nN, gid = wgid / nig, fm = gid * WGM;
        u.pm = fm + ((wgid % nig) % WGM); u.pn = (wgid % nig) / WGM; return true;
    }
};

template <class E> struct RowPerm { static constexpr bool value = false; };
template <class Epi>
__device__ __forceinline__ void gemm_phase_t(LAS unsigned char* lds, const Gemm g, const Epi& E, int tid_in) {
    int tid_ = tid_in; asm volatile("" : "+v"(tid_));
    const int tid = tid_, wid = __builtin_amdgcn_readfirstlane(tid >> 6), lane = tid & 63, wr = wid >> 2, wc = wid & 3, fr = lane & 15, fq = lane >> 4;
    const int K = g.K, nt = K / BK;
    StaticOrder S; S.init(g.nM, g.nN, (int)gdim(), (int)bidx());
    unsigned voffA[2], voffB[2];
#pragma unroll
    for (int i = 0; i < 2; ++i) { int R, C; stage_rc(tid * 16 + i * 8192, R, C); const int Rb = Epi::PERM ? ((R & ~31) + perm32(R & 31)) : R;
        const int Ra = RowPerm<Epi>::value ? ((R & ~63) | ((R & 15) << 2) | ((R >> 4) & 3)) : R;
        const int ao = g.a_packed ? ((R >> 4) * A2LD + (R & 15) * 16 + (C >> 4) * 384 + (C & 15)) : (Ra * g.lda + C);
        voffA[i] = (unsigned)ao * 2u; voffB[i] = (unsigned)(Rb * g.ldb + C) * 2u; }
    const long kA = g.a_kstep, kB = 128, hA = g.a_hstep, hB = g.b_hstep;
    const unsigned ldsw = (unsigned)wid * 1024u;
    const int aoff = lds_byte(wr * 64 + fr, fq * 8), boff = lds_byte(wc * 32 + fr, fq * 8);
#define PG8_SA(b, h) (((b) * 2 + (h)) * HTB)
#define PG8_SB(b, h) ((4 + (b) * 2 + (h)) * HTB)
#define PG8_STAGE(bufoff, gbase, voff) do { _Pragma("unroll") for (int _i = 0; _i < 2; ++_i) \
        __builtin_amdgcn_global_load_lds((const unsigned*)((const char*)(gbase) + (voff)[_i]), (LAS unsigned*)(lds + (bufoff) + ldsw + _i * 8192), 16, 0, 0); } while (0)
#define PG8_LDA(dst, b, h) do { _Pragma("unroll") for (int m = 0; m < 4; ++m) _Pragma("unroll") for (int k = 0; k < 2; ++k) dst[m][k] = *(const LAS bf16x8*)(lds + PG8_SA(b, h) + aoff + m * 2048 + k * 1024); } while (0)
#define PG8_LDB(dst, b, h) do { _Pragma("unroll") for (int n = 0; n < 2; ++n) _Pragma("unroll") for (int k = 0; k < 2; ++k) dst[n][k] = *(const LAS bf16x8*)(lds + PG8_SB(b, h) + boff + n * 2048 + k * 1024); } while (0)
#define PG8_MMA(ai, bj, At, Bt) do { __builtin_amdgcn_s_setprio(1); _Pragma("unroll") for (int m = 0; m < 4; ++m) _Pragma("unroll") for (int n = 0; n < 2; ++n) _Pragma("unroll") for (int k = 0; k < 2; ++k) \
        acc[ai][bj][m][n] = __builtin_amdgcn_mfma_f32_16x16x32_bf16(Bt[n][k], At[m][k], acc[ai][bj][m][n], 0, 0, 0); __builtin_amdgcn_s_setprio(0); } while (0)
#define PG8_WAIT_V(n) asm volatile("s_waitcnt vmcnt(" #n ")" ::: "memory")
#define PG8_WAIT_L(n) asm volatile("s_waitcnt lgkmcnt(" #n ")" ::: "memory")
#define PG8_BAR __builtin_amdgcn_s_barrier()
#define PG8_SCHED __builtin_amdgcn_sched_barrier(0)
    Unit cur, nxt; int ui = 0;
    if (!S.next(0, cur)) return;
    f32x4 acc[2][2][4][2];
#pragma unroll
    for (int a = 0; a < 2; ++a)
#pragma unroll
        for (int b = 0; b < 2; ++b)
#pragma unroll
            for (int m = 0; m < 4; ++m)
#pragma unroll
                for (int n = 0; n < 2; ++n) acc[a][b][m][n] = (f32x4){0.f, 0.f, 0.f, 0.f};
    bf16x8 At[4][2], B0[2][2], B1[2][2];
    const char* cA = (const char*)g.A + (size_t)cur.pm * g.a_tstep + (size_t)(cur.pn >> g.a_pn_shift) * g.a_pn_bytes;
    const char* cB = (const char*)g.Bt + (size_t)cur.pn * g.b_tstep;
    PG8_STAGE(PG8_SB(0, 0), cB, voffB); PG8_STAGE(PG8_SB(0, 1), cB + hB, voffB); PG8_STAGE(PG8_SA(0, 0), cA, voffA); PG8_STAGE(PG8_SA(0, 1), cA + hA, voffA);
    if (wr == 1) PG8_BAR;
    PG8_WAIT_V(2); PG8_BAR;
    PG8_STAGE(PG8_SB(1, 0), cB + kB, voffB); PG8_STAGE(PG8_SA(1, 0), cA + kA, voffA); PG8_STAGE(PG8_SB(1, 1), cB + hB + kB, voffB);
    PG8_WAIT_V(6); PG8_BAR;
    for (;;) {
        const bool has_next = S.next(ui + 1, nxt);
        const char* nA = has_next ? (const char*)g.A + (size_t)nxt.pm * g.a_tstep + (size_t)(nxt.pn >> g.a_pn_shift) * g.a_pn_bytes : cA;
        const char* nB = has_next ? (const char*)g.Bt + (size_t)nxt.pn * g.b_tstep : cB;
        for (int t = 0; t < nt; t += 2) {
            const bool last = (t == nt - 2);
            const char* a1 = cA + (size_t)(t + 1) * kA;
            const char* a2 = last ? nA : cA + (size_t)(t + 2) * kA; const char* b2 = last ? nB : cB + (size_t)(t + 2) * kB;
            const char* a3 = a2 + kA; const char* b3 = b2 + kB;
            PG8_LDB(B0, 0, 0); PG8_LDB(B1, 0, 1); PG8_SCHED; PG8_LDA(At, 0, 0); PG8_STAGE(PG8_SA(1, 1), a1 + hA, voffA);
            PG8_WAIT_V(8); PG8_WAIT_L(0); PG8_BAR; PG8_MMA(0, 0, At, B0); PG8_MMA(0, 1, At, B1); PG8_BAR; PG8_SCHED;
            PG8_LDA(At, 0, 1); PG8_STAGE(PG8_SB(0, 0), b2, voffB); PG8_STAGE(PG8_SB(0, 1), b2 + hB, voffB); PG8_STAGE(PG8_SA(0, 0), a2, voffA);
            PG8_WAIT_V(8); PG8_WAIT_L(0); PG8_BAR; PG8_MMA(1, 0, At, B0); PG8_MMA(1, 1, At, B1); PG8_BAR; PG8_SCHED;
            PG8_LDB(B0, 1, 0); PG8_LDB(B1, 1, 1); PG8_SCHED; PG8_LDA(At, 1, 0); PG8_STAGE(PG8_SA(0, 1), a2 + hA, voffA);
            PG8_WAIT_V(8); PG8_WAIT_L(0); PG8_BAR; PG8_MMA(0, 0, At, B0); PG8_MMA(0, 1, At, B1); PG8_BAR; PG8_SCHED;
            PG8_LDA(At, 1, 1); PG8_STAGE(PG8_SB(1, 0), b3, voffB); PG8_STAGE(PG8_SB(1, 1), b3 + hB, voffB); PG8_STAGE(PG8_SA(1, 0), a3, voffA);
            PG8_WAIT_V(8); PG8_WAIT_L(0); PG8_BAR; PG8_MMA(1, 0, At, B0); PG8_MMA(1, 1, At, B1); PG8_BAR; PG8_SCHED;
        }
        if (wr == 0) PG8_BAR;
        E(acc, cur, wr, wc, fr, fq);
        if (!has_next) break;
#pragma unroll
        for (int a = 0; a < 2; ++a)
#pragma unroll
            for (int b = 0; b < 2; ++b)
#pragma unroll
                for (int m = 0; m < 4; ++m)
#pragma unroll
                    for (int n = 0; n < 2; ++n) acc[a][b][m][n] = (f32x4){0.f, 0.f, 0.f, 0.f};
        cur = nxt; cA = nA; cB = nB; ++ui;
        if (wr == 1) PG8_BAR;
    }
    PG8_WAIT_V(0);
    PG8_BAR;
#undef PG8_SA
#undef PG8_SB
#undef PG8_STAGE
#undef PG8_LDA
#undef PG8_LDB
#undef PG8_MMA
#undef PG8_WAIT_V
#undef PG8_WAIT_L
#undef PG8_BAR
#undef PG8_SCHED
}

#define EPI_ARGS const f32x4 (&acc)[2][2][4][2], const Unit& u, int wr, int wc, int fr, int fq
#define ROW_LOOP _Pragma("unroll") for (int ai = 0; ai < 2; ++ai) _Pragma("unroll") for (int m = 0; m < 4; ++m)
__device__ __forceinline__ void get8(const f32x4 (&acc)[2][2][4][2], int ai, int bj, int m, float (&v)[8]) {
    const f32x4 a = acc[ai][bj][m][0], b = acc[ai][bj][m][1]; v[0] = a[0]; v[1] = a[1]; v[2] = a[2]; v[3] = a[3]; v[4] = b[0]; v[5] = b[1]; v[6] = b[2]; v[7] = b[3];
}

__device__ __forceinline__ float dpp_ror1(float v) { return __builtin_bit_cast(float, __builtin_amdgcn_update_dpp(__builtin_bit_cast(int, v), __builtin_bit_cast(int, v), 0x121, 0xf, 0xf, false)); }
__device__ __forceinline__ float dpp_ror2(float v) { return __builtin_bit_cast(float, __builtin_amdgcn_update_dpp(__builtin_bit_cast(int, v), __builtin_bit_cast(int, v), 0x122, 0xf, 0xf, false)); }
__device__ __forceinline__ float dpp_ror3(float v) { return __builtin_bit_cast(float, __builtin_amdgcn_update_dpp(__builtin_bit_cast(int, v), __builtin_bit_cast(int, v), 0x123, 0xf, 0xf, false)); }
__device__ __forceinline__ f32x4 ror3_4(const f32x4 v) { return (f32x4){dpp_ror3(v[0]), dpp_ror3(v[1]), dpp_ror3(v[2]), dpp_ror3(v[3])}; }
__device__ __forceinline__ float dpp_shr1(float v) { return __builtin_bit_cast(float, __builtin_amdgcn_update_dpp(__builtin_bit_cast(int, v), __builtin_bit_cast(int, v), 0x111, 0xf, 0xf, false)); }
__device__ __forceinline__ f32x4 shr1_4(const f32x4 v) { return (f32x4){dpp_shr1(v[0]), dpp_shr1(v[1]), dpp_shr1(v[2]), dpp_shr1(v[3])}; }
__device__ __forceinline__ f32x4 ror1_4(const f32x4 v) { return (f32x4){dpp_ror1(v[0]), dpp_ror1(v[1]), dpp_ror1(v[2]), dpp_ror1(v[3])}; }
__device__ __forceinline__ f32x4 ror2_4(const f32x4 v) { return (f32x4){dpp_ror2(v[0]), dpp_ror2(v[1]), dpp_ror2(v[2]), dpp_ror2(v[3])}; }
__device__ __forceinline__ f32x4 gelu4(const f32x4 v) { return (f32x4){gelu_t(v[0]), gelu_t(v[1]), gelu_t(v[2]), gelu_t(v[3])}; }
struct EpiIn {
    static constexpr bool PERM = true;
    const ss_t* ss; bf16_t* XC; bf16_t* GG; bf16_t* A2; float* HB4; const float* cw; const float* cb;
    __device__ __forceinline__ void operator()(EPI_ARGS) const {
        const int pn = u.pn;
        if (pn < 5) {
#pragma unroll
            for (int bj = 0; bj < 2; ++bj)
#pragma unroll
                for (int n = 0; n < 2; ++n) { const int c = pn * 256 + bj * 128 + wc * 32 + 8 * fq + 4 * n;
                    const f32x4 w0 = *(const f32x4*)(cw + c), w1 = *(const f32x4*)(cw + LW + c), w2 = *(const f32x4*)(cw + 2 * LW + c), w3 = *(const f32x4*)(cw + 3 * LW + c), bb = *(const f32x4*)(cb + c);
#pragma unroll
                    for (int ai = 0; ai < 2; ++ai) { const int rowb = u.pm * 256 + ai * 128 + wr * 64 + 4 * fr; f32x4 v[4];
#pragma unroll
                        for (int m = 0; m < 4; ++m) v[m] = acc[ai][bj][m][n] * rstd_of(ss[rowb + m]);
                        const int blk = u.pm * 4 + ai * 2 + wr;
                        if (fr == 0) { float* hp = HB4 + (size_t)blk * 6 * LW + c; *(f32x4*)hp = v[0]; *(f32x4*)(hp + LW) = v[1]; *(f32x4*)(hp + 2 * LW) = v[2]; }
                        if (fr == 15) { float* hp = HB4 + ((size_t)blk * 6 + 3) * LW + c; *(f32x4*)hp = v[1]; *(f32x4*)(hp + LW) = v[2]; *(f32x4*)(hp + 2 * LW) = v[3]; }
                        const f32x4 l1 = shr1_4(v[1]), l2 = shr1_4(v[2]), l3 = shr1_4(v[3]);
                        f32x4 o[4];
                        o[0] = bb + w0 * l1 + w1 * l2 + w2 * l3 + w3 * v[0];
                        o[1] = bb + w0 * l2 + w1 * l3 + w2 * v[0] + w3 * v[1];
                        o[2] = bb + w0 * l3 + w1 * v[0] + w2 * v[1] + w3 * v[2];
                        o[3] = bb + w0 * v[0] + w1 * v[1] + w2 * v[2] + w3 * v[3];
#pragma unroll
                        for (int m = 0; m < 4; ++m) { u32x2 w; w.x = pk_bf(o[m][0], o[m][1]); w.y = pk_bf(o[m][2], o[m][3]); *(u32x2*)(XC + (size_t)(rowb + m) * LW + c) = w; }
                        asm volatile("" ::: "memory"); } }
            return; }
        ROW_LOOP { const int row = u.pm * 256 + ai * 128 + wr * 64 + 4 * fr + m; const float rs = rstd_of(ss[row]);
#pragma unroll
            for (int bj = 0; bj < 2; ++bj) { const int col = pn * 256 + bj * 128 + wc * 32 + 8 * fq; float v[8]; get8(acc, ai, bj, m, v);
#pragma unroll
                for (int j = 0; j < 8; ++j) v[j] *= rs;
                if (pn < 10) {
#pragma unroll
                    for (int j = 0; j < 8; ++j) v[j] = gelu_t(v[j]);
                    *(u32x4*)(GG + (size_t)row * LW + (col - LW)) = pack8(v); }
                else { const int cc = col - 2 * LW, gi = cc >> 4, c16 = cc & 15;
                    *(u32x4*)(A2 + (size_t)(row >> 4) * A2LD + gi * 384 + (row & 15) * 16 + c16) = pack8(v); } } }
    }
};
template <> struct RowPerm<EpiIn> { static constexpr bool value = true; };
struct EpiG1 {
    static constexpr bool PERM = true;
    bf16_t* A2;
    __device__ __forceinline__ void operator()(EPI_ARGS) const {
        ROW_LOOP { const int r = u.pm * 256 + ai * 128 + wr * 64 + m * 16 + fr; float v[8]; get8(acc, ai, 0, m, v);
            *(u32x4*)(A2 + (size_t)r * A2LD + u.pn * 384 + 256 + wc * 32 + 8 * fq) = pack8(v); }
    }
};
struct EpiGate {
    static constexpr bool PERM = true;
    bf16_t* XC; bf16_t* UU; const float* gxb; const float* gab; const float* c8t;
    __device__ __forceinline__ void operator()(EPI_ARGS) const {
        const int ch0 = u.pn * 128 + wc * 32 + 8 * fq;
        ROW_LOOP { const int row = u.pm * 256 + ai * 128 + wr * 64 + m * 16 + fr; bf16_t* xp = XC + (size_t)row * LW + ch0;
            float xc[8], gx[8], ga[8]; unpack8(*(const u32x4*)xp, xc); get8(acc, ai, 0, m, gx); get8(acc, ai, 1, m, ga);
            const f32x4 bx0 = *(const f32x4*)(gxb + ch0), bx1 = *(const f32x4*)(gxb + ch0 + 4), ba0 = *(const f32x4*)(gab + ch0), ba1 = *(const f32x4*)(gab + ch0 + 4);
            const f32x4 c80 = *(const f32x4*)(c8t + ch0), c81 = *(const f32x4*)(c8t + ch0 + 4);
            float la[8], uu[8];
#pragma unroll
            for (int j = 0; j < 8; ++j) { const float bxj = j < 4 ? bx0[j & 3] : bx1[j & 3], baj = j < 4 ? ba0[j & 3] : ba1[j & 3], c8j = j < 4 ? c80[j & 3] : c81[j & 3];
                const float sx = sigmoidf_(gx[j] + bxj), sa = sigmoidf_(ga[j] + baj); la[j] = c8j * sa;
                const float x2 = 2.0f * la[j];
                const float pl = 1.0f + x2 * (0.5f + x2 * (0.16666667f + x2 * (0.041666667f + x2 * (0.0083333333f + x2 * 0.0013888889f))));
                const float m2 = x2 > -0.5f ? -x2 * pl : 1.0f - __builtin_amdgcn_exp2f(1.44269504f * x2);
                const float mult = __builtin_amdgcn_sqrtf(fmaxf(m2, 1e-12f)); uu[j] = mult * sx * xc[j]; }
            u32x4 w; w.x = pk_h(la[0], la[1]); w.y = pk_h(la[2], la[3]); w.z = pk_h(la[4], la[5]); w.w = pk_h(la[6], la[7]);
            *(u32x4*)xp = w; *(u32x4*)(UU + (size_t)row * LW + ch0) = pack8(uu);
            if (m == 3) asm volatile("" ::: "memory"); }
    }
};
struct EpiG2 {
    static constexpr bool PERM = true;
    bf16_t* A2; const float* dd;
    __device__ __forceinline__ void operator()(EPI_ARGS) const {
        const int c0 = (8 * fq) & 15; float dv[8];
#pragma unroll
        for (int j = 0; j < 8; ++j) dv[j] = dd[u.pn * 16 + c0 + j];
        ROW_LOOP { const int r = u.pm * 256 + ai * 128 + wr * 64 + m * 16 + fr;
#pragma unroll
            for (int bj = 0; bj < 2; ++bj) { const int col = bj * 128 + wc * 32 + 8 * fq; bf16_t* p = A2 + (size_t)r * A2LD + u.pn * 384 + col;
                float v[8], uv[8]; get8(acc, ai, bj, m, v); unpack8(*(const u32x4*)p, uv);
#pragma unroll
                for (int j = 0; j < 8; ++j) v[j] = gelu_t(v[j] + dv[j] * uv[j]);
                *(u32x4*)p = pack8(v); }
            if (m == 3) asm volatile("" ::: "memory"); }
    }
};
struct EpiGlu {
    static constexpr bool PERM = true;
    bf16_t* YB; const float* bias;
    __device__ __forceinline__ void operator()(EPI_ARGS) const {
        const int oc = u.pn * 128 + wc * 32 + 8 * fq; float b0[8], b1[8];
#pragma unroll
        for (int j = 0; j < 8; ++j) { b0[j] = bias[oc + j]; b1[j] = bias[D + oc + j]; }
        ROW_LOOP { const int row = u.pm * 256 + ai * 128 + wr * 64 + m * 16 + fr; float a[8], b[8]; get8(acc, ai, 0, m, a); get8(acc, ai, 1, m, b);
#pragma unroll
            for (int j = 0; j < 8; ++j) a[j] = (a[j] + b0[j]) * sigmoidf_(b[j] + b1[j]);
            *(u32x4*)(YB + (size_t)row * D + oc) = pack8(a); }
    }
};
struct EpiBf {
    static constexpr bool PERM = true;
    bf16_t* O; int ldo; const ss_t* ss;
    __device__ __forceinline__ void operator()(EPI_ARGS) const {
        ROW_LOOP { const int row = u.pm * 256 + ai * 128 + wr * 64 + m * 16 + fr; const float rs = ss ? rstd_of(ss[row]) : 1.0f;
#pragma unroll
            for (int bj = 0; bj < 2; ++bj) { float v[8]; get8(acc, ai, bj, m, v);
#pragma unroll
                for (int j = 0; j < 8; ++j) v[j] *= rs;
                *(u32x4*)(O + (size_t)row * ldo + u.pn * 256 + bj * 128 + wc * 32 + 8 * fq) = pack8(v); } }
    }
};

struct EpiUp {
    static constexpr bool PERM = true;
    const ss_t* ss; bf16_t* H; float* HB; const float* cw; const float* cb;
    __device__ __forceinline__ void operator()(EPI_ARGS) const {
        const int cbase = u.pn * 128 + wc * 32 + 8 * fq;
#pragma unroll
        for (int n = 0; n < 2; ++n) { const int c = cbase + 4 * n;
            const f32x4 wa0 = *(const f32x4*)(cw + c), wa1 = *(const f32x4*)(cw + 2 * DFF + c), wa2 = *(const f32x4*)(cw + 4 * DFF + c), ba = *(const f32x4*)(cb + c);
            const f32x4 wb0 = *(const f32x4*)(cw + DFF + c), wb1 = *(const f32x4*)(cw + 3 * DFF + c), wb2 = *(const f32x4*)(cw + 5 * DFF + c), bb = *(const f32x4*)(cb + DFF + c);
#pragma unroll
            for (int ai = 0; ai < 2; ++ai) { const int rowb = u.pm * 256 + ai * 128 + wr * 64 + 4 * fr; f32x4 va[4], vb[4];
#pragma unroll
                for (int m = 0; m < 4; ++m) { const float rs = rstd_of(ss[rowb + m]); va[m] = acc[ai][0][m][n] * rs; vb[m] = acc[ai][1][m][n] * rs; }
                const int blk = u.pm * 4 + ai * 2 + wr;
                if (fr == 0) { float* hp = HB + (size_t)blk * 4 * (2 * DFF) + c; *(f32x4*)hp = va[0]; *(f32x4*)(hp + DFF) = vb[0]; *(f32x4*)(hp + 2 * DFF) = va[1]; *(f32x4*)(hp + 3 * DFF) = vb[1]; }
                if (fr == 15) { float* hp = HB + ((size_t)blk * 4 + 2) * (2 * DFF) + c; *(f32x4*)hp = va[2]; *(f32x4*)(hp + DFF) = vb[2]; *(f32x4*)(hp + 2 * DFF) = va[3]; *(f32x4*)(hp + 3 * DFF) = vb[3]; }
                const f32x4 la2 = shr1_4(va[2]), la3 = shr1_4(va[3]), lb2 = shr1_4(vb[2]), lb3 = shr1_4(vb[3]);
                f32x4 ca[4], cv[4];
                ca[0] = ba + wa0 * la2 + wa1 * la3 + wa2 * va[0];   cv[0] = bb + wb0 * lb2 + wb1 * lb3 + wb2 * vb[0];
                ca[1] = ba + wa0 * la3 + wa1 * va[0] + wa2 * va[1]; cv[1] = bb + wb0 * lb3 + wb1 * vb[0] + wb2 * vb[1];
                ca[2] = ba + wa0 * va[0] + wa1 * va[1] + wa2 * va[2]; cv[2] = bb + wb0 * vb[0] + wb1 * vb[1] + wb2 * vb[2];
                ca[3] = ba + wa0 * va[1] + wa1 * va[2] + wa2 * va[3]; cv[3] = bb + wb0 * vb[1] + wb1 * vb[2] + wb2 * vb[3];
#pragma unroll
                for (int m = 0; m < 4; ++m) { const f32x4 h = gelu4(ca[m]) * cv[m]; u32x2 w; w.x = pk_bf(h[0], h[1]); w.y = pk_bf(h[2], h[3]);
                    *(u32x2*)(H + (size_t)(rowb + m) * DFF + c) = w; }
                asm volatile("" ::: "memory"); } }
    }
};
template <> struct RowPerm<EpiUp> { static constexpr bool value = true; };
struct EpiMerge {
    static constexpr bool PERM = true;
    const ss_t* ss; bf16_t* YA; const bf16_t* YB;
    __device__ __forceinline__ void operator()(EPI_ARGS) const {
        const int oc = u.pn * 128 + wc * 32 + 8 * fq;
        ROW_LOOP { const int row = u.pm * 256 + ai * 128 + wr * 64 + m * 16 + fr; const float rs = rstd_of(ss[row]);
            float a[8], b[8], ya[8], yb[8]; get8(acc, ai, 0, m, a); get8(acc, ai, 1, m, b);
            unpack8(*(const u32x4*)(YA + (size_t)row * D + oc), ya); unpack8(*(const u32x4*)(YB + (size_t)row * D + oc), yb);
#pragma unroll
            for (int j = 0; j < 8; ++j) a[j] = sigmoidf_(rs * a[j]) * ya[j] + sigmoidf_(rs * b[j]) * yb[j];
            *(u32x4*)(YA + (size_t)row * D + oc) = pack8(a); }
    }
};
template <int MODE> struct EpiRes {
    static constexpr bool PERM = true;
    const float* x32; float* X; const bf16_t* XBin; bf16_t* XBout; ss_t* ss_out; const ss_t* ss_in; const bf16_t* PP;
    __device__ __forceinline__ void operator()(EPI_ARGS) const {
        ROW_LOOP { const int row = u.pm * 256 + ai * 128 + wr * 64 + m * 16 + fr; float rs = 1.0f; if (MODE != 0) rs = rstd_of(ss_in[row]);
            float q = 0.f;
#pragma unroll
            for (int bj = 0; bj < 2; ++bj) { const size_t off = (size_t)row * D + u.pn * 256 + bj * 128 + wc * 32 + 8 * fq;
                float a[8], xv[8]; get8(acc, ai, bj, m, a);
                if (MODE == 0 && x32) { const f32x4 x0 = *(const f32x4*)(x32 + off), x1 = *(const f32x4*)(x32 + off + 4); xv[0] = x0[0]; xv[1] = x0[1]; xv[2] = x0[2]; xv[3] = x0[3]; xv[4] = x1[0]; xv[5] = x1[1]; xv[6] = x1[2]; xv[7] = x1[3]; }
                else unpack8(*(const u32x4*)(XBin + off), xv);
                if (MODE != 0) { float pp[8]; unpack8(*(const u32x4*)(PP + off), pp);
#pragma unroll
                    for (int j = 0; j < 8; ++j) a[j] = sigmoidf_(rs * a[j]) * pp[j]; }
#pragma unroll
                for (int j = 0; j < 8; ++j) a[j] += xv[j];
                if (MODE != 1) { const u32x4 w = pack8(a); *(u32x4*)(XBout + off) = w; unpack8(w, a); }
                else { *(f32x4*)(X + off) = (f32x4){a[0], a[1], a[2], a[3]}; *(f32x4*)(X + off + 4) = (f32x4){a[4], a[5], a[6], a[7]}; }
#pragma unroll
                for (int j = 0; j < 8; ++j) q += a[j] * a[j]; }
            q += __shfl_xor(q, 16); q += __shfl_xor(q, 32);
            if (fq == 0) atomicAdd(ss_out + row, ss_fix(q));
            if (m == 3) asm volatile("" ::: "memory"); }
    }
};

struct Params { const float* in[32]; float* out; unsigned char* ws; };
enum { I_X = 0, I_P, I_GMIX, I_WIN, I_CAW, I_CAB, I_GXW, I_GXB, I_GAW, I_GAB, I_LAM, I_WAO, I_SARE, I_SAIM, I_SLDT, I_SBRE, I_SBIM, I_SCRE, I_SCIM, I_SD,
       I_WGLU, I_BGLU, I_WO, I_GFFN, I_WUP, I_CFW, I_CFB, I_WDN, I_GPLE, I_WPG, I_WPP, I_GFIN };

constexpr int TBL_OFF = 131072 + 4096;
struct Ctx { unsigned char* ws_; float* out_; LAS unsigned char* lds; int wid;
    __device__ __forceinline__ int tid() const { int lane; asm volatile("v_mbcnt_lo_u32_b32 %0, -1, 0\n\tv_mbcnt_hi_u32_b32 %0, -1, %0" : "=v"(lane)); return wid * 64 + lane; }
    __device__ __forceinline__ unsigned char* wsl() const { unsigned char* w = ws_; asm volatile("" : "+s"(w)); return w; }
    __device__ __forceinline__ float* outl() const { float* w = out_; asm volatile("" : "+s"(w)); return w; }
    __device__ __forceinline__ const float* in(int i) const { unsigned off = TBL_OFF + 8 * i; asm volatile("" : "+s"(off)); const LAS unsigned* t = (const LAS unsigned*)(lds + off);
        const unsigned lo = __builtin_amdgcn_readfirstlane(t[0]), hi = __builtin_amdgcn_readfirstlane(t[1]); return (const float*)(((unsigned long long)hi << 32) | lo); } };
__device__ __forceinline__ void tr_item(const float* src, int ldn, int k0, int c0, const float* scale, bf16_t* dst, int ldk, int drow0, int dk0, LAS unsigned short* s, int lane) {
    const int r4 = lane >> 4, c4 = (lane & 15) * 4;
    f32x4 v[16];
#pragma unroll
    for (int i = 0; i < 16; ++i) v[i] = *(const f32x4*)(src + (size_t)(k0 + i * 4 + r4) * ldn + c0 + c4);
#pragma unroll
    for (int i = 0; i < 16; ++i) { const int row = i * 4 + r4; f32x4 x = v[i]; if (scale) x = x * scale[k0 + row];
        s[(c4 + 0) * 66 + row] = f2bf(x[0]); s[(c4 + 1) * 66 + row] = f2bf(x[1]); s[(c4 + 2) * 66 + row] = f2bf(x[2]); s[(c4 + 3) * 66 + row] = f2bf(x[3]); }
    asm volatile("s_waitcnt lgkmcnt(0)" ::: "memory");
#pragma unroll 8
    for (int r = 0; r < 32; ++r) { const int n = r * 2 + (lane >> 5), kk = lane & 31; const unsigned w = *(const LAS unsigned*)(s + n * 66 + kk * 2);
        *(unsigned*)(dst + (size_t)(drow0 + n) * ldk + dk0 + kk * 2) = w; }
    asm volatile("s_waitcnt lgkmcnt(0)" ::: "memory");
}

__device__ __forceinline__ void s5_lam(float are, float aim, float dt, float pw, float& re, float& im) { const float mag = expf(are * dt * pw); float rev = aim * dt * pw * 0.15915494309f; rev -= floorf(rev);
    re = mag * __builtin_amdgcn_cosf(rev); im = mag * __builtin_amdgcn_sinf(rev); }
__device__ __forceinline__ void s5_coef(float are, float aim, float dt, float& cre, float& cim) {
    float lr, li; s5_lam(are, aim, dt, 1.0f, lr, li); const float nr = lr - 1.0f, ni = li, den = are * are + aim * aim;
    cre = (nr * are + ni * aim) / den; cim = (ni * are - nr * aim) / den;
}

__device__ __forceinline__ void phase0(const Ctx& P, int l, LAS unsigned char* lds) {
    int tid_ = P.tid(); asm volatile("" : "+v"(tid_));
    const int tid = tid_, lane = tid & 63, wave = tid >> 6;
    const int gw = bidx() * NWAVES + wave, NGW = gdim() * NWAVES;
    const int gt = bidx() * NTHREADS + tid, NGT = gdim() * NTHREADS;
    unsigned char* ws = P.wsl(); bf16_t* W = (bf16_t*)(ws + WS_W);
    LAS unsigned short* scr = (LAS unsigned short*)(lds + wave * 16384);
    const float* gmix = P.in(I_GMIX) + l * D; const float* gffn = P.in(I_GFFN) + l * D; const float* gple = P.in(I_GPLE) + l * D;
    const float* win = P.in(I_WIN) + (size_t)l * D * NIN;
    constexpr int C0 = 16 * 56, C1 = 16 * 32, C2 = 20 * 16, C3 = 16 * 32, C4 = 256, C5 = 16 * 96, C6 = 48 * 16, C7 = 256, C8 = 4 * 16, C9 = 80;
    constexpr int CT = C0 + C1 + C2 + C3 + C4 + C5 + C6 + C7 + C8 + C9;
    for (int item = gw; item < CT; item += NGW) {
        int it = item;
        if (it < C0) { const int kb = it % 16, nb = it / 16; tr_item(win, NIN, kb * 64, nb * 64, gmix, W + W_IN, D, nb * 64, kb * 64, scr, lane); continue; } it -= C0;
        if (it < C1) { const int kb = it % 16, nb = it / 16, n0 = nb * 64, c0 = 3584 + ((n0 >> 7) & 1) * 1024 + (n0 >> 8) * 128 + (n0 & 127);
            tr_item(win, NIN, kb * 64, c0, gmix, W + W_MG, D, n0, kb * 64, scr, lane); continue; } it -= C1;
        if (it < C2) { const int kb = it % 20, nb = it / 20; tr_item(P.in(I_WAO) + (size_t)l * LW * D, D, kb * 64, nb * 64, nullptr, W + W_AO, LW, nb * 64, kb * 64, scr, lane); continue; } it -= C2;
        if (it < C3) { const int kb = it % 16, nb = it / 16, n0 = nb * 64, c0 = ((n0 >> 7) & 1) * 1024 + (n0 >> 8) * 128 + (n0 & 127);
            tr_item(P.in(I_WGLU) + (size_t)l * D * 2 * D, 2 * D, kb * 64, c0, nullptr, W + W_GLU, D, n0, kb * 64, scr, lane); continue; } it -= C3;
        if (it < C4) { const int kb = it % 16, nb = it / 16; tr_item(P.in(I_WO) + (size_t)l * D * D, D, kb * 64, nb * 64, nullptr, W + W_O, D, nb * 64, kb * 64, scr, lane); continue; } it -= C4;
        if (it < C5) { const int kb = it % 16, nb = it / 16, n0 = nb * 64, c0 = ((n0 >> 7) & 1) * DFF + (n0 >> 8) * 128 + (n0 & 127);
            tr_item(P.in(I_WUP) + (size_t)l * D * 2 * DFF, 2 * DFF, kb * 64, c0, gffn, W + W_UP, D, n0, kb * 64, scr, lane); continue; } it -= C5;
        if (it < C6) { const int kb = it % 48, nb = it / 48; tr_item(P.in(I_WDN) + (size_t)l * DFF * D, D, kb * 64, nb * 64, nullptr, W + W_DN, DFF, nb * 64, kb * 64, scr, lane); continue; } it -= C6;
        if (it < C7) { const int kb = it % 16, nb = it / 16; tr_item(P.in(I_WPG) + (size_t)l * D * D, D, kb * 64, nb * 64, gple, W + W_PG, D, nb * 64, kb * 64, scr, lane); continue; } it -= C7;
        if (it < C8) { const int kb = it % 4, nb = it / 4; tr_item(P.in(I_WPP) + (size_t)l * PLE * D, D, kb * 64, nb * 64, nullptr, W + W_PP, PLE, nb * 64, kb * 64, scr, lane); continue; } it -= C8;
        { const int j = it >> 2, h = j >> 1, bj = j & 1, sub = it & 3, kb = sub & 1, nb = sub >> 1;
          const float* src = (bj ? P.in(I_GAW) : P.in(I_GXW)) + (size_t)(l * 10 + h) * 128 * 128;
          tr_item(src, 128, kb * 64, nb * 64, nullptr, W + W_GATE, 128, h * 256 + bj * 128 + nb * 64, kb * 64, scr, lane); }
    }
    { float* c8 = (float*)(ws + WS_C8); const float* lam = P.in(I_LAM) + l * LW; for (int i = gt; i < LW; i += NGT) c8[i] = -8.0f * log1pf(__expf(-lam[i])); }
    const float* are = P.in(I_SARE) + l * 4096; const float* aim = P.in(I_SAIM) + l * 4096; const float* ldt = P.in(I_SLDT) + l * 64;
    const float* bre = P.in(I_SBRE) + (size_t)l * 65536; const float* bim = P.in(I_SBIM) + (size_t)l * 65536;
    const float* cre = P.in(I_SCRE) + (size_t)l * 65536; const float* cim = P.in(I_SCIM) + (size_t)l * 65536;
    float* KD = (float*)(ws + WS_KD);
    for (int i = (wave * gdim() + bidx()) * 64 + lane; i < 64 * 16 * 16 * 4; i += NGT) { const int pq = i & 3, co = (i >> 2) & 15, d = (i >> 6) & 15, g = i >> 10; const float dt = expf(ldt[g]);
        float a16[16];
#pragma unroll
        for (int c = 0; c < 16; ++c) a16[c] = 0.f;
#pragma unroll 4
        for (int pp = 0; pp < 16; ++pp) { const int p = pq * 16 + pp; const float ar = are[g * 64 + p], ai = aim[g * 64 + p]; float lr, li, kr, ki; s5_lam(ar, ai, dt, (float)d, lr, li); s5_coef(ar, ai, dt, kr, ki);
            const float cr = cre[(g * 16 + co) * 64 + p], ci = cim[(g * 16 + co) * 64 + p];
            const float t_r = cr * lr - ci * li, t_i = cr * li + ci * lr; const float w_r = t_r * kr - t_i * ki, w_i = t_r * ki + t_i * kr;
            const float* br = bre + (size_t)(g * 64 + p) * 16; const float* bi = bim + (size_t)(g * 64 + p) * 16;
#pragma unroll
            for (int c = 0; c < 16; ++c) a16[c] += w_r * br[c] - w_i * bi[c]; }
#pragma unroll
        for (int c = 0; c < 16; ++c) { a16[c] += __shfl_xor(a16[c], 1); a16[c] += __shfl_xor(a16[c], 2); }
        if (pq == 0) {
#pragma unroll
            for (int c = 0; c < 16; ++c) KD[(size_t)(i >> 2) * 16 + c] = a16[c]; } }
    for (int i = gt; i < 64 * 256 * 16; i += NGT) { const int j = i & 15, n = (i >> 4) & 255, g = i >> 12; bf16_t* dst = W + W_T1 + ((size_t)(g * 256 + n) * 256 + j * 16);
        float v[16];
        if (n < 128) { const int p = n & 63; const float dt = expf(ldt[g]), ar = are[g * 64 + p], ai = aim[g * 64 + p]; float lr, li, kr, ki; s5_lam(ar, ai, dt, (float)(15 - j), lr, li); s5_coef(ar, ai, dt, kr, ki);
            const float w_r = lr * kr - li * ki, w_i = lr * ki + li * kr; const float* br = bre + (size_t)(g * 64 + p) * 16; const float* bi = bim + (size_t)(g * 64 + p) * 16;
#pragma unroll
            for (int c = 0; c < 16; ++c) v[c] = (n < 64) ? (w_r * br[c] - w_i * bi[c]) : (w_r * bi[c] + w_i * br[c]); }
        else {
#pragma unroll
            for (int c = 0; c < 16; ++c) v[c] = 0.f; }
        u32x4 w0, w1; w0.x = pk_bf(v[0], v[1]); w0.y = pk_bf(v[2], v[3]); w0.z = pk_bf(v[4], v[5]); w0.w = pk_bf(v[6], v[7]); w1.x = pk_bf(v[8], v[9]); w1.y = pk_bf(v[10], v[11]); w1.z = pk_bf(v[12], v[13]); w1.w = pk_bf(v[14], v[15]);
        *(u32x4*)dst = w0; *(u32x4*)(dst + 8) = w1; }
    for (int i = gt; i < 64 * 16 * 64; i += NGT) { const int p = i & 63, t = (i >> 6) & 15, g = i >> 10; const float dt = expf(ldt[g]); float lr, li; s5_lam(are[g * 64 + p], aim[g * 64 + p], dt, (float)(t + 1), lr, li);
        for (int co = 0; co < 16; ++co) { const float cr = cre[(g * 16 + co) * 64 + p], ci = cim[(g * 16 + co) * 64 + p]; bf16_t* dst = W + W_T2 + (size_t)(g * 256 + t * 16 + co) * 384 + 256 + p;
            dst[0] = f2bf(cr * lr - ci * li); dst[64] = f2bf(-(cr * li + ci * lr)); } }
    { const float* pp = P.in(I_P) + (size_t)l * M * PLE; bf16_t* PB = (bf16_t*)(ws + WS_PB);
      for (size_t i = gt; i < (size_t)M * PLE / 8; i += (size_t)4 * NGT) { f32x4 a[4], b[4];
#pragma unroll
          for (int j = 0; j < 4; ++j) { const size_t k = i + (size_t)j * NGT; if (k < (size_t)M * PLE / 8) { a[j] = *(const f32x4*)(pp + k * 8); b[j] = *(const f32x4*)(pp + k * 8 + 4); } }
#pragma unroll
          for (int j = 0; j < 4; ++j) { const size_t k = i + (size_t)j * NGT; if (k < (size_t)M * PLE / 8) {
              u32x4 w; w.x = pk_bf(a[j][0], a[j][1]); w.y = pk_bf(a[j][2], a[j][3]); w.z = pk_bf(b[j][0], b[j][1]); w.w = pk_bf(b[j][2], b[j][3]); *(u32x4*)(PB + k * 8) = w; } } } }
    if (l == 0) {
        ss_t* SS = (ss_t*)(ws + WS_SS); bf16_t* XB = (bf16_t*)(ws + WS_XB); const float* x = P.in(I_X);
        for (int i = gt; i < 6 * M; i += NGT) SS[M + i] = 0ull;
        for (int row = gw; row < M; row += 4 * NGW) { f32x4 v[4][4];
#pragma unroll
            for (int r = 0; r < 4; ++r) { const int rr = row + r * NGW; if (rr < M) {
#pragma unroll
                for (int j = 0; j < 4; ++j) v[r][j] = *(const f32x4*)(x + (size_t)rr * D + j * 256 + lane * 4); } }
#pragma unroll
            for (int r = 0; r < 4; ++r) { const int rr = row + r * NGW; if (rr < M) { float q = 0.f;
#pragma unroll
                for (int j = 0; j < 4; ++j) { const f32x4 t = v[r][j]; q += (t[0] * t[0] + t[1] * t[1]) + (t[2] * t[2] + t[3] * t[3]);
                    u32x2 w; w.x = pk_bf(t[0], t[1]); w.y = pk_bf(t[2], t[3]); *(u32x2*)(XB + (size_t)rr * D + j * 256 + lane * 4) = w; }
                q = wave_sum(q); if (lane == 0) SS[rr] = ss_fix(q); } } }
    }
}

__device__ __forceinline__ void fill_t2(const Ctx& P) {
    int gt_ = bidx() * NTHREADS + P.tid(); asm volatile("" : "+v"(gt_)); const int gt = gt_, NGT = gdim() * NTHREADS;
    const float* KD = (const float*)(P.wsl() + WS_KD); bf16_t* W = (bf16_t*)(P.wsl() + WS_W);
    for (int i = gt; i < 64 * 256 * 16; i += NGT) { const int s = i & 15, n = (i >> 4) & 255, g = i >> 12, t = n >> 4, co = n & 15; bf16_t* dst = W + W_T2 + (size_t)(g * 256 + n) * 384 + s * 16;
        u32x4 w0 = (u32x4){0u, 0u, 0u, 0u}, w1 = w0;
        if (s <= t) { const float* k = KD + ((size_t)((g * 16 + (t - s)) * 16 + co)) * 16; const f32x4 a = *(const f32x4*)k, b = *(const f32x4*)(k + 4), c = *(const f32x4*)(k + 8), d = *(const f32x4*)(k + 12);
            w0.x = pk_bf(a[0], a[1]); w0.y = pk_bf(a[2], a[3]); w0.z = pk_bf(b[0], b[1]); w0.w = pk_bf(b[2], b[3]); w1.x = pk_bf(c[0], c[1]); w1.y = pk_bf(c[2], c[3]); w1.z = pk_bf(d[0], d[1]); w1.w = pk_bf(d[2], d[3]); }
        *(u32x4*)dst = w0; *(u32x4*)(dst + 8) = w1; }
}

__device__ __forceinline__ void fixup_xc(const Ctx& P, int l) {
    int tid_ = P.tid(); asm volatile("" : "+v"(tid_)); const int tid = tid_;
    const float* HB4 = (const float*)(P.wsl() + WS_HB4); bf16_t* XC = (bf16_t*)(P.wsl() + WS_R3);
    const float* cw = P.in(I_CAW) + (size_t)l * 4 * LW; const float* cb = P.in(I_CAB) + (size_t)l * LW;
    StaticOrder S; S.init(128, 10, gdim(), bidx()); Unit u;
    for (int ui = 0; S.next(ui, u); ++ui) {
        for (int i = tid; i < 4 * 128; i += NTHREADS) { const int bl = i >> 7, c = u.pn * 128 + (i & 127), blk = u.pm * 4 + bl; const bool first = (blk & 63) == 0;
            const float* hb = HB4 + (size_t)blk * 6 * LW + c; const float* pb = hb - 6 * LW;
            const float t3 = first ? 0.f : pb[3 * LW], t2 = first ? 0.f : pb[4 * LW], t1 = first ? 0.f : pb[5 * LW], h0 = hb[0], h1 = hb[LW], h2 = hb[2 * LW];
            const float w0 = cw[c], w1 = cw[LW + c], w2 = cw[2 * LW + c], w3 = cw[3 * LW + c], bb = cb[c];
            bf16_t* xp = XC + (size_t)blk * 64 * LW + c;
            xp[0] = f2bf(bb + w0 * t3 + w1 * t2 + w2 * t1 + w3 * h0);
            xp[LW] = f2bf(bb + w0 * t2 + w1 * t1 + w2 * h0 + w3 * h1);
            xp[2 * LW] = f2bf(bb + w0 * t1 + w1 * h0 + w2 * h1 + w3 * h2); } }
    asm volatile("s_waitcnt vmcnt(0)" ::: "memory");
    __syncthreads();
}

__device__ __forceinline__ void s5_carry(const Ctx& P, int l) {
    int tid_ = P.tid(); asm volatile("" : "+v"(tid_));
    const int tid = tid_, lane = tid & 63, wave = tid >> 6;
    for (int gwv = wave * gdim() + bidx(); gwv < 512; gwv += 2 * gdim()) {
    const int idx = gwv * 64 + lane, p = idx & 63, g = (idx >> 6) & 63, b = idx >> 12;
    const float dt = expf(P.in(I_SLDT)[l * 64 + g]); float lr, li; s5_lam(P.in(I_SARE)[l * 4096 + g * 64 + p], P.in(I_SAIM)[l * 4096 + g * 64 + p], dt, 16.0f, lr, li);
    bf16_t* base = (bf16_t*)(P.wsl() + WS_A2) + (size_t)(b * 256) * A2LD + g * 384 + 256 + p;
    float sr = 0.f, si = 0.f;
    for (int cb = 0; cb < 8; ++cb) { float er[32], ei[32];
#pragma unroll
        for (int k = 0; k < 32; ++k) { const bf16_t* q = base + (size_t)(cb * 32 + k) * A2LD; er[k] = bf2f(q[0]); ei[k] = bf2f(q[64]); }
#pragma unroll
        for (int k = 0; k < 32; ++k) { bf16_t* q = base + (size_t)(cb * 32 + k) * A2LD; q[0] = f2bf(sr); q[64] = f2bf(si);
            const float nr = lr * sr - li * si + er[k], ni = lr * si + li * sr + ei[k]; sr = nr; si = ni; } }
    }
}

__device__ __forceinline__ void lru_scan_a(const Ctx& P) {
    int gt_ = bidx() * 384 + (P.tid() - 128); asm volatile("" : "+v"(gt_)); const int gt = gt_, NGT = gdim() * 384;
    const unsigned* LA = (const unsigned*)(P.wsl() + WS_R3); const unsigned* UU = (const unsigned*)(P.wsl() + WS_R1); float4* SUM = (float4*)(P.wsl() + WS_SUM);
    for (int i = gt; i < 8 * 64 * 640; i += NGT) { const int c2 = i % 640, bk = i / 640; const size_t o = (size_t)bk * 64 * 640 + c2;
        float p0 = 1.f, p1 = 1.f, h0 = 0.f, h1 = 0.f;
        for (int tb = 0; tb < 4; ++tb) { unsigned lw[16], uw[16];
#pragma unroll
            for (int t = 0; t < 16; ++t) { lw[t] = LA[o + (size_t)(tb * 16 + t) * 640]; uw[t] = UU[o + (size_t)(tb * 16 + t) * 640]; }
#pragma unroll
            for (int t = 0; t < 16; ++t) { const h16x2 lh = __builtin_bit_cast(h16x2, lw[t]);
                const float a0 = __expf((float)lh.x), a1 = __expf((float)lh.y); h0 = a0 * h0 + lo_bf(uw[t]); h1 = a1 * h1 + hi_bf(uw[t]); p0 *= a0; p1 *= a1; } }
        SUM[i] = make_float4(p0, h0, p1, h1); }
}
__device__ __forceinline__ void lru_scan_c(const Ctx& P) {
    int gt_ = bidx() * NTHREADS + P.tid(); asm volatile("" : "+v"(gt_)); const int gt = gt_, NGT = gdim() * NTHREADS;
    const unsigned* LA = (const unsigned*)(P.wsl() + WS_R3); unsigned* UU = (unsigned*)(P.wsl() + WS_R1); const unsigned* GG = (const unsigned*)(P.wsl() + WS_R2); const float4* SUM = (const float4*)(P.wsl() + WS_SUM);
    for (int i = gt; i < 8 * 64 * 640; i += NGT) { const int c2 = i % 640, bk = i / 640, k = bk & 63, b = bk >> 6; const size_t o = (size_t)bk * 64 * 640 + c2;
        float h0 = 0.f, h1 = 0.f;
        for (int kb = 0; kb < k; kb += 8) { float4 sv[8];
#pragma unroll
            for (int j = 0; j < 8; ++j) sv[j] = (kb + j < k) ? SUM[(size_t)(b * 64 + kb + j) * 640 + c2] : make_float4(1.f, 0.f, 1.f, 0.f);
#pragma unroll
            for (int j = 0; j < 8; ++j) { h0 = sv[j].x * h0 + sv[j].y; h1 = sv[j].z * h1 + sv[j].w; } }
        for (int tb = 0; tb < 4; ++tb) { unsigned lw[16], uw[16], gw[16];
#pragma unroll
            for (int t = 0; t < 16; ++t) { const size_t a = o + (size_t)(tb * 16 + t) * 640; lw[t] = LA[a]; uw[t] = UU[a]; gw[t] = GG[a]; }
#pragma unroll
            for (int t = 0; t < 16; ++t) { const size_t a = o + (size_t)(tb * 16 + t) * 640; const h16x2 lh = __builtin_bit_cast(h16x2, lw[t]);
                const float a0 = __expf((float)lh.x), a1 = __expf((float)lh.y); h0 = a0 * h0 + lo_bf(uw[t]); h1 = a1 * h1 + hi_bf(uw[t]);
                UU[a] = pk_bf(h0 * lo_bf(gw[t]), h1 * hi_bf(gw[t])); } } }
}
__device__ __forceinline__ void fixup_h(const Ctx& P, int l) {
    int tid_ = P.tid(); asm volatile("" : "+v"(tid_)); const int tid = tid_;
    const float* HB = (const float*)(P.wsl() + WS_HB); bf16_t* H = (bf16_t*)(P.wsl() + WS_H);
    const float* cw = P.in(I_CFW) + (size_t)l * 3 * 2 * DFF; const float* cb = P.in(I_CFB) + (size_t)l * 2 * DFF;
    StaticOrder S; S.init(128, 4, gdim(), bidx()); Unit u;
    for (int ui = 0; S.next(ui, u); ++ui) {
        for (int i = tid; i < 4 * 768; i += NTHREADS) { const int bl = i / 768, c = (i - bl * 768) * 4, blk = u.pm * 4 + bl; const bool first = (blk & 63) == 0;
            const float* hb = HB + (size_t)blk * 4 * (2 * DFF) + c; const float* pb = hb - 4 * (2 * DFF);
            const f32x4 z = (f32x4){0.f, 0.f, 0.f, 0.f};
            const f32x4 a_m2 = first ? z : *(const f32x4*)(pb + 2 * (2 * DFF)), a_m1 = first ? z : *(const f32x4*)(pb + 3 * (2 * DFF)), a_0 = *(const f32x4*)hb, a_1 = *(const f32x4*)(hb + 2 * DFF);
            const f32x4 b_m2 = first ? z : *(const f32x4*)(pb + 2 * (2 * DFF) + DFF), b_m1 = first ? z : *(const f32x4*)(pb + 3 * (2 * DFF) + DFF), b_0 = *(const f32x4*)(hb + DFF), b_1 = *(const f32x4*)(hb + 2 * DFF + DFF);
            const f32x4 wa0 = *(const f32x4*)(cw + c), wa1 = *(const f32x4*)(cw + 2 * DFF + c), wa2 = *(const f32x4*)(cw + 4 * DFF + c), ba = *(const f32x4*)(cb + c);
            const f32x4 wb0 = *(const f32x4*)(cw + DFF + c), wb1 = *(const f32x4*)(cw + 3 * DFF + c), wb2 = *(const f32x4*)(cw + 5 * DFF + c), bb = *(const f32x4*)(cb + DFF + c);
            const f32x4 ca0 = ba + wa0 * a_m2 + wa1 * a_m1 + wa2 * a_0, cb0 = bb + wb0 * b_m2 + wb1 * b_m1 + wb2 * b_0;
            const f32x4 ca1 = ba + wa0 * a_m1 + wa1 * a_0 + wa2 * a_1, cb1 = bb + wb0 * b_m1 + wb1 * b_0 + wb2 * b_1;
            const f32x4 h0 = gelu4(ca0) * cb0, h1 = gelu4(ca1) * cb1; u32x2 w0, w1; w0.x = pk_bf(h0[0], h0[1]); w0.y = pk_bf(h0[2], h0[3]); w1.x = pk_bf(h1[0], h1[1]); w1.y = pk_bf(h1[2], h1[3]);
            bf16_t* hp = H + (size_t)blk * 64 * DFF + c; *(u32x2*)hp = w0; *(u32x2*)(hp + DFF) = w1; } }
    asm volatile("s_waitcnt vmcnt(0)" ::: "memory");
    __syncthreads();
}
__device__ __forceinline__ void final_norm(const Ctx& P) {
    int tid_ = P.tid(); asm volatile("" : "+v"(tid_));
    const int tid = tid_, lane = tid & 63, wave = tid >> 6; const int gw = bidx() * NWAVES + wave, NGW = gdim() * NWAVES;
    const ss_t* SS = (const ss_t*)(P.wsl() + WS_SS) + 6 * M; const float* gf = P.in(I_GFIN); float* X = P.outl();
    for (int row = gw; row < M; row += 2 * NGW) { f32x4 v[2][4]; float rs[2];
#pragma unroll
        for (int r = 0; r < 2; ++r) { const int rr = row + r * NGW; if (rr < M) { rs[r] = rstd_of(SS[rr]);
#pragma unroll
            for (int j = 0; j < 4; ++j) v[r][j] = *(const f32x4*)(X + (size_t)rr * D + j * 256 + lane * 4); } }
#pragma unroll
        for (int r = 0; r < 2; ++r) { const int rr = row + r * NGW; if (rr < M) {
#pragma unroll
            for (int j = 0; j < 4; ++j) { const f32x4 gv = *(const f32x4*)(gf + j * 256 + lane * 4); *(f32x4*)(X + (size_t)rr * D + j * 256 + lane * 4) = v[r][j] * rs[r] * gv; } } } }
}

#define XB_TMO      128
#define XB_XCNT(j)  (256  + 64 * (j))
#define XB_XSUB(j)  (1280 + 64 * (j))
#define XB_XGEN(j)  (2304 + 64 * (j))
#define XB_TOP      3328
#define XB_TOPGEN   3392
#define XCD_BAR_WORDS 3456
#define XB_SPIN_CAP (1u << 22)
__device__ __forceinline__ unsigned xb_ld(unsigned* p)              { return __hip_atomic_load(p, __ATOMIC_RELAXED, __HIP_MEMORY_SCOPE_AGENT); }
__device__ __forceinline__ unsigned xb_add(unsigned* p, unsigned v) { return __hip_atomic_fetch_add(p, v, __ATOMIC_RELAXED, __HIP_MEMORY_SCOPE_AGENT); }
__device__ __forceinline__ unsigned xb_xcc_id() { return (unsigned)__builtin_amdgcn_s_getreg((3 << 11) | 20) & 0xFu; }
#define XB_SPIN(cond, bar) do { unsigned _sp = 0; while (cond) { __builtin_amdgcn_s_sleep(1); \
    if ((++_sp & 255u) == 0u) { if (xb_ld(&(bar)[XB_TMO])) break; if (_sp > XB_SPIN_CAP) { atomicAdd(&(bar)[XB_TMO], 1u); break; } } } } while (0)
struct XcdBarrier { unsigned* bar; unsigned x; volatile LAS unsigned* st; };
__device__ __forceinline__ XcdBarrier xcd_barrier_post(unsigned* bar, volatile LAS unsigned* st) {
    XcdBarrier b; b.bar = bar; b.x = xb_xcc_id(); b.st = st;
    if (threadIdx.x == 0) (void)xb_add(&bar[XB_XCNT(b.x)], 1u);
    return b;
}
__device__ __forceinline__ void xcd_barrier_complete(unsigned* bar, unsigned x_, unsigned& nloc, unsigned& nx) {
    unsigned x = x_;
    const unsigned G = gridDim.x * gridDim.y * gridDim.z;
    asm volatile("" : "+s"(x));
    unsigned sum, cnt, mine, sp = 0u;
    for (;;) {
        sum = 0u; cnt = 0u; mine = 0u;
#pragma unroll
        for (unsigned j = 0; j < 16; ++j) { const unsigned c = xb_ld(&bar[XB_XCNT(j)]); sum += c; cnt += (c > 0u) ? 1u : 0u; mine = (j == x) ? c : mine; }
        if (sum == G) break;
        __builtin_amdgcn_s_sleep(1);
        if ((++sp & 255u) == 0u) { if (xb_ld(&bar[XB_TMO])) break; if (sp > XB_SPIN_CAP) { atomicAdd(&bar[XB_TMO], 1u); break; } }
    }
    nloc = mine > 0u ? mine : 1u; nx = cnt > 0u ? cnt : 1u;
}
__device__ __forceinline__ void xcd_barrier(const XcdBarrier& b, int tid) {
    asm volatile("s_waitcnt vmcnt(0)" ::: "memory");
    __syncthreads();
    if (tid == 0) {
        unsigned* bar = b.bar;
        __builtin_amdgcn_s_waitcnt(0);
        unsigned nloc = b.st[0], nx = b.st[1];
        if (nloc == 0u) { xcd_barrier_complete(bar, b.x, nloc, nx); b.st[0] = nloc; b.st[1] = nx; }
        const unsigned old = xb_add(&bar[XB_XSUB(b.x)], 1u);
        const unsigned gen = old / nloc;
        if (old + 1u == (gen + 1u) * nloc) {
            __builtin_amdgcn_fence(__ATOMIC_RELEASE, "agent");
            asm volatile("s_waitcnt vmcnt(0)" ::: "memory");
            const unsigned og = xb_add(&bar[XB_TOP], 1u);
            const unsigned tg = og / nx;
            if (og + 1u == (tg + 1u) * nx) xb_add(&bar[XB_TOPGEN], 1u);
            else XB_SPIN(xb_ld(&bar[XB_TOPGEN]) == tg, bar);
            __builtin_amdgcn_fence(__ATOMIC_ACQUIRE, "agent");
            xb_add(&bar[XB_XGEN(b.x)], 1u);
            asm volatile("s_waitcnt vmcnt(0)" ::: "memory");
        } else {
            XB_SPIN(xb_ld(&bar[XB_XGEN(b.x)]) == gen, bar);
            __builtin_amdgcn_fence(__ATOMIC_ACQUIRE, "agent");
            asm volatile("s_waitcnt vmcnt(0)" ::: "memory");
        }
    }
    __syncthreads();
}

#define WSB(off) ((bf16_t*)(P.wsl() + (off)))
#define SSP(k) ((ss_t*)(P.wsl() + WS_SS) + (size_t)(k) * M)
#define gemm_phase(lds_, g_, E_) gemm_phase_t(lds_, g_, E_, P.tid())
#define SYNC() do { xcd_barrier(xbar, P.tid()); } while (0)
#define SYNC_CG() do { __syncthreads(); grid.sync(); } while (0)
template <int l> __device__ __forceinline__ void layer_fwd(const Ctx& P, LAS unsigned char* lds, cg::grid_group& grid, const XcdBarrier& xbar) {


        phase0(P, l, lds);
        if (l == 0 && P.ws_ == nullptr) SYNC_CG();
        SYNC();
#define XBL ((l == 0) ? WSB(WS_XB) : (bf16_t*)P.outl())
        { Gemm g = mk_gemm(XBL, D, WSB(WS_W) + W_IN, D, 128, 14);
          EpiIn E{SSP(3 * l), WSB(WS_R3), WSB(WS_R2), WSB(WS_A2), (float*)(P.wsl() + WS_HB4), P.in(I_CAW) + (size_t)l * 4 * LW, P.in(I_CAB) + (size_t)l * LW}; gemm_phase(lds, g, E); }
        SYNC();
        { Gemm g = mk_gemm(WSB(WS_A2), A2LD, WSB(WS_W) + W_T1, 256, 8, 64); g.a_pn_bytes = 768; EpiG1 E{WSB(WS_A2)}; gemm_phase(lds, g, E); }
        fill_t2(P);
        fixup_xc(P, l);
        { Gemm g = mk_gemm(WSB(WS_R3), LW, WSB(WS_W) + W_GATE, 128, 128, 10); g.a_pn_bytes = 256;
          EpiGate E{WSB(WS_R3), WSB(WS_R1), P.in(I_GXB) + l * LW, P.in(I_GAB) + l * LW, (const float*)(P.wsl() + WS_C8)}; gemm_phase(lds, g, E); }
        SYNC();
        if (P.wid < 2) s5_carry(P, l); else lru_scan_a(P);
        SYNC();
        for (int sb = 0; sb < 2; ++sb) {
            if ((sb ^ (bidx() & 1)) == 0) lru_scan_c(P);
            else { Gemm g = mk_gemm(WSB(WS_A2), A2LD, WSB(WS_W) + W_T2, 384, 8, 64); g.a_pn_bytes = 768; EpiG2 E{WSB(WS_A2), P.in(I_SD) + l * D}; gemm_phase(lds, g, E); }
            __syncthreads(); }
        SYNC();
        { Gemm g = mk_gemm(WSB(WS_A2), 0, WSB(WS_W) + W_GLU, D, 128, 8); g.a_packed = 1; g.a_tstep = (long)16 * A2LD * 2; g.a_hstep = (long)8 * A2LD * 2; g.a_kstep = 1536 * 2;
          EpiGlu E{WSB(WS_R3), P.in(I_BGLU) + l * 2 * D}; gemm_phase(lds, g, E); }
        { Gemm g = mk_gemm(WSB(WS_R1), LW, WSB(WS_W) + W_AO, LW, 128, 4); EpiBf E{WSB(WS_R2), D, nullptr}; gemm_phase(lds, g, E); }
        SYNC();
        { Gemm g = mk_gemm(XBL, D, WSB(WS_W) + W_MG, D, 128, 8); EpiMerge E{SSP(3 * l), WSB(WS_R2), WSB(WS_R3)}; gemm_phase(lds, g, E); }
        SYNC();
        { Gemm g = mk_gemm(WSB(WS_R2), D, WSB(WS_W) + W_O, D, 128, 4); EpiRes<0> E{l == 0 ? P.in(I_X) : nullptr, nullptr, XBL, WSB(WS_XB), SSP(3 * l + 1), nullptr, nullptr}; gemm_phase(lds, g, E); }
        SYNC();
        { Gemm g = mk_gemm(WSB(WS_XB), D, WSB(WS_W) + W_UP, D, 128, 24);
          EpiUp E{SSP(3 * l + 1), WSB(WS_H), (float*)(P.wsl() + WS_HB), P.in(I_CFW) + (size_t)l * 3 * 2 * DFF, P.in(I_CFB) + (size_t)l * 2 * DFF}; gemm_phase(lds, g, E); }
        { Gemm g = mk_gemm(WSB(WS_PB), PLE, WSB(WS_W) + W_PP, PLE, 128, 4); EpiBf E{WSB(WS_PP), D, nullptr}; gemm_phase(lds, g, E); }
        SYNC();
        fixup_h(P, l);
        { Gemm g = mk_gemm(WSB(WS_H), DFF, WSB(WS_W) + W_DN, DFF, 128, 4);
          EpiRes<0> E{nullptr, nullptr, WSB(WS_XB), WSB(WS_XB), SSP(3 * l + 2), nullptr, nullptr}; gemm_phase(lds, g, E); }
        SYNC();
        { Gemm g = mk_gemm(WSB(WS_XB), D, WSB(WS_W) + W_PG, D, 128, 4);
          if (l == DEPTH - 1) { EpiRes<1> E{nullptr, P.outl(), WSB(WS_XB), nullptr, SSP(3 * l + 3), SSP(3 * l + 2), WSB(WS_PP)}; gemm_phase(lds, g, E); }
          else { EpiRes<2> E{nullptr, nullptr, WSB(WS_XB), (bf16_t*)P.outl(), SSP(3 * l + 3), SSP(3 * l + 2), WSB(WS_PP)}; gemm_phase(lds, g, E); } }
        SYNC();
    }

__global__ void __launch_bounds__(NTHREADS, 2) fwd_kernel(Params KP) {
    extern __shared__ __attribute__((aligned(16))) unsigned char lds_raw[];
    LAS unsigned char* lds = (LAS unsigned char*)lds_raw;
    cg::grid_group grid = cg::this_grid();
    if (threadIdx.x == 0) { LAS unsigned long long* t = (LAS unsigned long long*)(lds + TBL_OFF);
#pragma unroll
        for (int i = 0; i < 32; ++i) t[i] = (unsigned long long)KP.in[i]; }
    if (threadIdx.x < 4) ((LAS unsigned*)(lds + TBL_OFF + 512))[threadIdx.x] = 0u;
    __syncthreads();
    Ctx P; P.ws_ = KP.ws; P.out_ = KP.out; P.lds = lds; P.wid = __builtin_amdgcn_readfirstlane(threadIdx.x >> 6);
    XcdBarrier xbar = xcd_barrier_post((unsigned*)(KP.ws + WS_BAR), (volatile LAS unsigned*)(lds + TBL_OFF + 512));
    layer_fwd<0>(P, lds, grid, xbar);
    layer_fwd<1>(P, lds, grid, xbar);
    final_norm(P);
}

extern "C" void kernel_launch(void* const* d_in, const int* in_sizes, int n_in, void* d_out, int out_size, void* d_ws, size_t ws_size, hipStream_t stream) {
    static int grid = 0;
    if (grid == 0) {
        int dev = 0, cus = 0, per_cu = 0;
        (void)hipGetDevice(&dev); (void)hipDeviceGetAttribute(&cus, hipDeviceAttributeMultiprocessorCount, dev);
        (void)hipFuncSetAttribute((const void*)fwd_kernel, hipFuncAttributeMaxDynamicSharedMemorySize, LDS_BYTES);
        if (hipOccupancyMaxActiveBlocksPerMultiprocessor(&per_cu, (const void*)fwd_kernel, NTHREADS, LDS_BYTES) != hipSuccess || per_cu < 1) per_cu = 1;
        (void)hipGetLastError();
        grid = cus * per_cu;
        if (ws_size < 512 * MiB) fprintf(stderr, "kernel_launch: workspace %zu < 512 MiB\n", ws_size);
    }
    (void)hipMemsetAsync((char*)d_ws + WS_BAR, 0, XCD_BAR_WORDS * 4, stream);
    Params p{};
    for (int i = 0; i < 32; ++i) p.in[i] = (const float*)d_in[i];
    p.out = (float*)d_out; p.ws = (unsigned char*)d_ws;
    void* args[] = {&p};
    hipError_t e = hipLaunchCooperativeKernel((const void*)fwd_kernel, dim3(grid), dim3(NTHREADS), args, LDS_BYTES, stream);
    if (e != hipSuccess) fprintf(stderr, "cooperative launch failed: %s (grid %d)\n", hipGetErrorString(e), grid);
}
```

```cpp
#include <hip/hip_runtime.h>
#include <hip/hip_cooperative_groups.h>
#include <cstdio>
#include <cstdint>
namespace cg = cooperative_groups;

#define LAS __attribute__((address_space(3)))
typedef unsigned short bf16_t;
typedef short bf16x8 __attribute__((ext_vector_type(8)));
typedef float f32x4 __attribute__((ext_vector_type(4)));
typedef float f32x2 __attribute__((ext_vector_type(2)));
typedef unsigned u32x4 __attribute__((ext_vector_type(4)));
typedef unsigned u32x2 __attribute__((ext_vector_type(2)));
typedef _Float16 h16x2 __attribute__((ext_vector_type(2)));

constexpr int M = 32768, SEQ = 4096, D = 1024, LW = 1280, NIN = 5632, DFF = 3072, PLE = 256, DEPTH = 2;
constexpr float EPS = 1e-6f;
constexpr int A2LD = 24576;
constexpr int NTHREADS = 512, NWAVES = 8;
constexpr int LDS_BYTES = 131072 + 8192;

constexpr size_t MiB = 1u << 20;
constexpr size_t WS_SS = 502 * MiB;
constexpr size_t WS_C8 = 0;
constexpr size_t WS_KD = 1 * MiB;
constexpr size_t WS_SUM = 2 * MiB;
constexpr size_t WS_BAR = 7 * MiB;
constexpr size_t WS_W = 8 * MiB;
constexpr size_t WS_XB = 70 * MiB;
constexpr size_t WS_R1 = 134 * MiB;
constexpr size_t WS_R2 = 214 * MiB;
constexpr size_t WS_A2 = 294 * MiB;
constexpr size_t WS_R3 = 390 * MiB;
constexpr size_t WS_H = 134 * MiB;
constexpr size_t WS_HB = 326 * MiB;
constexpr size_t WS_PP = 422 * MiB;
constexpr size_t WS_HB4 = 470 * MiB;
constexpr size_t WS_PB = 486 * MiB;
constexpr size_t W_IN = 0;
constexpr size_t W_MG = W_IN + (size_t)3584 * 1024;
constexpr size_t W_GATE = W_MG + (size_t)2048 * 1024;
constexpr size_t W_AO = W_GATE + (size_t)2560 * 256;
constexpr size_t W_GLU = W_AO + (size_t)1024 * 1280;
constexpr size_t W_O = W_GLU + (size_t)2048 * 1024;
constexpr size_t W_UP = W_O + (size_t)1024 * 1024;
constexpr size_t W_DN = W_UP + (size_t)6144 * 1024;
constexpr size_t W_PG = W_DN + (size_t)1024 * 3072;
constexpr size_t W_PP = W_PG + (size_t)1024 * 1024;
constexpr size_t W_T1 = W_PP + (size_t)1024 * 256;
constexpr size_t W_T2 = W_T1 + (size_t)64 * 256 * 256;
constexpr size_t W_END = W_T2 + (size_t)64 * 256 * 384;
static_assert(W_END * 2 <= 62 * MiB, "weight region");

__device__ __forceinline__ unsigned pk_bf(float lo, float hi) { unsigned r; asm volatile("v_cvt_pk_bf16_f32 %0, %1, %2" : "=v"(r) : "v"(lo), "v"(hi)); return r; }
__device__ __forceinline__ bf16_t f2bf(float f) { return (bf16_t)(pk_bf(f, 0.f) & 0xffffu); }
__device__ __forceinline__ float bf2f(bf16_t b) { return __uint_as_float(((unsigned)b) << 16); }
__device__ __forceinline__ float lo_bf(unsigned w) { return __uint_as_float(w << 16); }
__device__ __forceinline__ float hi_bf(unsigned w) { return __uint_as_float(w & 0xffff0000u); }
__device__ __forceinline__ float sigmoidf_(float x) { return __builtin_amdgcn_rcpf(1.0f + __builtin_amdgcn_exp2f(-1.44269504f * x)); }
__device__ __forceinline__ float gelu_t(float x) { const float t = x * x; return x * __builtin_amdgcn_rcpf(1.0f + __builtin_amdgcn_exp2f(x * (-2.3022082f - 0.1029432f * t))); }
__device__ __forceinline__ void unpack8(const u32x4 w, float (&v)[8]) { v[0] = lo_bf(w.x); v[1] = hi_bf(w.x); v[2] = lo_bf(w.y); v[3] = hi_bf(w.y); v[4] = lo_bf(w.z); v[5] = hi_bf(w.z); v[6] = lo_bf(w.w); v[7] = hi_bf(w.w); }
__device__ __forceinline__ u32x4 pack8(const float (&v)[8]) { u32x4 w; w.x = pk_bf(v[0], v[1]); w.y = pk_bf(v[2], v[3]); w.z = pk_bf(v[4], v[5]); w.w = pk_bf(v[6], v[7]); return w; }
__device__ __forceinline__ unsigned pk_h(float a, float b) { h16x2 h; h.x = (_Float16)a; h.y = (_Float16)b; return __builtin_bit_cast(unsigned, h); }
typedef unsigned long long ss_t;
__device__ __forceinline__ float rstd_of(ss_t v) { return rsqrtf((float)v * (1.0f / 16777216.0f) * (1.0f / D) + EPS); }
__device__ __forceinline__ ss_t ss_fix(float q) { return (ss_t)(q * 16777216.0f); }
__device__ __forceinline__ float wave_sum(float v) {
#pragma unroll
    for (int o = 32; o >= 1; o >>= 1) v += __shfl_xor(v, o);
    return v;
}

__device__ __forceinline__ int bidx() { int b = blockIdx.x; asm volatile("" : "+s"(b)); return b; }
__device__ __forceinline__ int gdim() { int g = gridDim.x; asm volatile("" : "+s"(g)); return g; }
constexpr int BM = 256, BK = 64, HALF = 128, HTB = HALF * BK * 2, STAGE_BYTES = 8 * HTB, NXCD = 8, WGM = 8;
__device__ __forceinline__ int lds_byte(int r, int c) { const int st = (r >> 4) * 2 + (c >> 5), rr = r & 15, cc = c & 31, ob = rr * 64 + cc * 2; return st * 1024 + (ob ^ (((ob >> 9) & 1) << 5)); }
__device__ __forceinline__ void stage_rc(int b, int& R, int& C) { const int st = b / 1024, sb = b % 1024, swz = sb ^ (((sb >> 9) & 1) << 5); R = (st >> 1) * 16 + swz / 64; C = (st & 1) * 32 + (swz % 64) / 2; }
__device__ __forceinline__ int perm32(int rho) { const int n = rho >> 4, i = rho & 15; return 8 * (i >> 2) + 4 * n + (i & 3); }

struct Unit { int pm, pn; };
struct Gemm {
    const bf16_t* A; const bf16_t* Bt; int K;
    int lda, ldb, a_packed;
    long a_tstep, a_hstep, a_kstep;
    long b_tstep, b_hstep;
    long a_pn_bytes; int a_pn_shift;
    int nM, nN;
};
__device__ __forceinline__ Gemm mk_gemm(const bf16_t* A, int lda, const bf16_t* Bt, int K, int nM, int nN) {
    Gemm g; g.A = A; g.Bt = Bt; g.K = K; g.lda = lda; g.ldb = K; g.a_packed = 0;
    g.a_tstep = (long)256 * lda * 2; g.a_hstep = (long)128 * lda * 2; g.a_kstep = 128;
    g.b_tstep = (long)256 * K * 2; g.b_hstep = (long)128 * K * 2; g.a_pn_bytes = 0; g.a_pn_shift = 0; g.nM = nM; g.nN = nN; return g;
}
struct StaticOrder {
    int nM, nN, nwg, G, c;
    __device__ void init(int nM_, int nN_, int G_, int c_) { nM = nM_; nN = nN_; nwg = nM * nN; G = G_; c = c_; }
    __device__ bool next(int i, Unit& u) const {
        const long L = (long)i * G + c; if (L >= nwg) return false;
        int wgid = (int)L; { const int q = nwg / NXCD, r = nwg % NXCD, xcd = wgid % NXCD, off = wgid / NXCD; wgid = (xcd < r ? xcd * (q + 1) : r * (q + 1) + (xcd - r) * q) + off; }
        const int nig = WGM * nN, gid = wgid / nig, fm = gid * WGM;
        u.pm = fm + ((wgid % nig) % WGM); u.pn = (wgid % nig) / WGM; return true;
    }
};

template <class E> struct RowPerm { static constexpr bool value = false; };
template <class Epi>
__device__ __forceinline__ void gemm_phase_t(LAS unsigned char* lds, const Gemm g, const Epi& E, int tid_in) {
    int tid_ = tid_in; asm volatile("" : "+v"(tid_));
    const int tid = tid_, wid = __builtin_amdgcn_readfirstlane(tid >> 6), lane = tid & 63, wr = wid >> 2, wc = wid & 3, fr = lane & 15, fq = lane >> 4;
    const int K = g.K, nt = K / BK;
    StaticOrder S; S.init(g.nM, g.nN, (int)gdim(), (int)bidx());
    unsigned voffA[2], voffB[2];
#pragma unroll
    for (int i = 0; i < 2; ++i) { int R, C; stage_rc(tid * 16 + i * 8192, R, C); const int Rb = Epi::PERM ? ((R & ~31) + perm32(R & 31)) : R;
        const int Ra = RowPerm<Epi>::value ? ((R & ~63) | ((R & 15) << 2) | ((R >> 4) & 3)) : R;
        const int ao = g.a_packed ? ((R >> 4) * A2LD + (R & 15) * 16 + (C >> 4) * 384 + (C & 15)) : (Ra * g.lda + C);
        voffA[i] = (unsigned)ao * 2u; voffB[i] = (unsigned)(Rb * g.ldb + C) * 2u; }
    const long kA = g.a_kstep, kB = 128, hA = g.a_hstep, hB = g.b_hstep;
    const unsigned ldsw = (unsigned)wid * 1024u;
    const int aoff = lds_byte(wr * 64 + fr, fq * 8), boff = lds_byte(wc * 32 + fr, fq * 8);
#define PG8_SA(b, h) (((b) * 2 + (h)) * HTB)
#define PG8_SB(b, h) ((4 + (b) * 2 + (h)) * HTB)
#define PG8_STAGE(bufoff, gbase, voff) do { _Pragma("unroll") for (int _i = 0; _i < 2; ++_i) \
        __builtin_amdgcn_global_load_lds((const unsigned*)((const char*)(gbase) + (voff)[_i]), (LAS unsigned*)(lds + (bufoff) + ldsw + _i * 8192), 16, 0, 0); } while (0)
#define PG8_LDA(dst, b, h) do { _Pragma("unroll") for (int m = 0; m < 4; ++m) _Pragma("unroll") for (int k = 0; k < 2; ++k) dst[m][k] = *(const LAS bf16x8*)(lds + PG8_SA(b, h) + aoff + m * 2048 + k * 1024); } while (0)
#define PG8_LDB(dst, b, h) do { _Pragma("unroll") for (int n = 0; n < 2; ++n) _Pragma("unroll") for (int k = 0; k < 2; ++k) dst[n][k] = *(const LAS bf16x8*)(lds + PG8_SB(b, h) + boff + n * 2048 + k * 1024); } while (0)
#define PG8_MMA(ai, bj, At, Bt) do { __builtin_amdgcn_s_setprio(1); _Pragma("unroll") for (int m = 0; m < 4; ++m) _Pragma("unroll") for (int n = 0; n < 2; ++n) _Pragma("unroll") for (int k = 0; k < 2; ++k) \
        acc[ai][bj][m][n] = __builtin_amdgcn_mfma_f32_16x16x32_bf16(Bt[n][k], At[m][k], acc[ai][bj][m][n], 0, 0, 0); __builtin_amdgcn_s_setprio(0); } while (0)
#define PG8_WAIT_V(n) asm volatile("s_waitcnt vmcnt(" #n ")" ::: "memory")
#define PG8_WAIT_L(n) asm volatile("s_waitcnt lgkmcnt(" #n ")" ::: "memory")
#define PG8_BAR __builtin_amdgcn_s_barrier()
#define PG8_SCHED __builtin_amdgcn_sched_barrier(0)
    Unit cur, nxt; int ui = 0;
    if (!S.next(0, cur)) return;
    f32x4 acc[2][2][4][2];
#pragma unroll
    for (int a = 0; a < 2; ++a)
#pragma unroll
        for (int b = 0; b < 2; ++b)
#pragma unroll
            for (int m = 0; m < 4; ++m)
#pragma unroll
                for (int n = 0; n < 2; ++n) acc[a][b][m][n] = (f32x4){0.f, 0.f, 0.f, 0.f};
    bf16x8 At[4][2], B0[2][2], B1[2][2];
    const char* cA = (const char*)g.A + (size_t)cur.pm * g.a_tstep + (size_t)(cur.pn >> g.a_pn_shift) * g.a_pn_bytes;
    const char* cB = (const char*)g.Bt + (size_t)cur.pn * g.b_tstep;
    PG8_STAGE(PG8_SB(0, 0), cB, voffB); PG8_STAGE(PG8_SB(0, 1), cB + hB, voffB); PG8_STAGE(PG8_SA(0, 0), cA, voffA); PG8_STAGE(PG8_SA(0, 1), cA + hA, voffA);
    if (wr == 1) PG8_BAR;
    PG8_WAIT_V(2); PG8_BAR;
    PG8_STAGE(PG8_SB(1, 0), cB + kB, voffB); PG8_STAGE(PG8_SA(1, 0), cA + kA, voffA); PG8_STAGE(PG8_SB(1, 1), cB + hB + kB, voffB);
    PG8_WAIT_V(6); PG8_BAR;
    for (;;) {
        const bool has_next = S.next(ui + 1, nxt);
        const char* nA = has_next ? (const char*)g.A + (size_t)nxt.pm * g.a_tstep + (size_t)(nxt.pn >> g.a_pn_shift) * g.a_pn_bytes : cA;
        const char* nB = has_next ? (const char*)g.Bt + (size_t)nxt.pn * g.b_tstep : cB;
        for (int t = 0; t < nt; t += 2) {
            const bool last = (t == nt - 2);
            const char* a1 = cA + (size_t)(t + 1) * kA;
            const char* a2 = last ? nA : cA + (size_t)(t + 2) * kA; const char* b2 = last ? nB : cB + (size_t)(t + 2) * kB;
            const char* a3 = a2 + kA; const char* b3 = b2 + kB;
            PG8_LDB(B0, 0, 0); PG8_LDB(B1, 0, 1); PG8_SCHED; PG8_LDA(At, 0, 0); PG8_STAGE(PG8_SA(1, 1), a1 + hA, voffA);
            PG8_WAIT_V(8); PG8_WAIT_L(0); PG8_BAR; PG8_MMA(0, 0, At, B0); PG8_MMA(0, 1, At, B1); PG8_BAR; PG8_SCHED;
            PG8_LDA(At, 0, 1); PG8_STAGE(PG8_SB(0, 0), b2, voffB); PG8_STAGE(PG8_SB(0, 1), b2 + hB, voffB); PG8_STAGE(PG8_SA(0, 0), a2, voffA);
            PG8_WAIT_V(8); PG8_WAIT_L(0); PG8_BAR; PG8_MMA(1, 0, At, B0); PG8_MMA(1, 1, At, B1); PG8_BAR; PG8_SCHED;
            PG8_LDB(B0, 1, 0); PG8_LDB(B1, 1, 1); PG8_SCHED; PG8_LDA(At, 1, 0); PG8_STAGE(PG8_SA(0, 1), a2 + hA, voffA);
            PG8_WAIT_V(8); PG8_WAIT_L(0); PG8_BAR; PG8_MMA(0, 0, At, B0); PG8_MMA(0, 1, At, B1); PG8_BAR; PG8_SCHED;
            PG8_LDA(At, 1, 1); PG8_STAGE(PG8_SB(1, 0), b3, voffB); PG8_STAGE(PG8_SB(1, 1), b3 + hB, voffB); PG8_STAGE(PG8_SA(1, 0), a3, voffA);
            PG8_WAIT_V(8); PG8_WAIT_L(0); PG8_BAR; PG8_MMA(1, 0, At, B0); PG8_MMA(1, 1, At, B1); PG8_BAR; PG8_SCHED;
        }
        if (wr == 0) PG8_BAR;
        E(acc, cur, wr, wc, fr, fq);
        if (!has_next) break;
#pragma unroll
        for (int a = 0; a < 2; ++a)
#pragma unroll
            for (int b = 0; b < 2; ++b)
#pragma unroll
                for (int m = 0; m < 4; ++m)
#pragma unroll
                    for (int n = 0; n < 2; ++n) acc[a][b][m][n] = (f32x4){0.f, 0.f, 0.f, 0.f};
        cur = nxt; cA = nA; cB = nB; ++ui;
        if (wr == 1) PG8_BAR;
    }
    PG8_WAIT_V(0);
    PG8_BAR;
#undef PG8_SA
#undef PG8_SB
#undef PG8_STAGE
#undef PG8_LDA
#undef PG8_LDB
#undef PG8_MMA
#undef PG8_WAIT_V
#undef PG8_WAIT_L
#undef PG8_BAR
#undef PG8_SCHED
}

#define EPI_ARGS const f32x4 (&acc)[2][2][4][2], const Unit& u, int wr, int wc, int fr, int fq
#define ROW_LOOP _Pragma("unroll") for (int ai = 0; ai < 2; ++ai) _Pragma("unroll") for (int m = 0; m < 4; ++m)
__device__ __forceinline__ void get8(const f32x4 (&acc)[2][2][4][2], int ai, int bj, int m, float (&v)[8]) {
    const f32x4 a = acc[ai][bj][m][0], b = acc[ai][bj][m][1]; v[0] = a[0]; v[1] = a[1]; v[2] = a[2]; v[3] = a[3]; v[4] = b[0]; v[5] = b[1]; v[6] = b[2]; v[7] = b[3];
}

__device__ __forceinline__ float dpp_ror1(float v) { return __builtin_bit_cast(float, __builtin_amdgcn_update_dpp(__builtin_bit_cast(int, v), __builtin_bit_cast(int, v), 0x121, 0xf, 0xf, false)); }
__device__ __forceinline__ float dpp_ror2(float v) { return __builtin_bit_cast(float, __builtin_amdgcn_update_dpp(__builtin_bit_cast(int, v), __builtin_bit_cast(int, v), 0x122, 0xf, 0xf, false)); }
__device__ __forceinline__ float dpp_ror3(float v) { return __builtin_bit_cast(float, __builtin_amdgcn_update_dpp(__builtin_bit_cast(int, v), __builtin_bit_cast(int, v), 0x123, 0xf, 0xf, false)); }
__device__ __forceinline__ f32x4 ror3_4(const f32x4 v) { return (f32x4){dpp_ror3(v[0]), dpp_ror3(v[1]), dpp_ror3(v[2]), dpp_ror3(v[3])}; }
__device__ __forceinline__ float dpp_shr1(float v) { return __builtin_bit_cast(float, __builtin_amdgcn_update_dpp(__builtin_bit_cast(int, v), __builtin_bit_cast(int, v), 0x111, 0xf, 0xf, false)); }
__device__ __forceinline__ f32x4 shr1_4(const f32x4 v) { return (f32x4){dpp_shr1(v[0]), dpp_shr1(v[1]), dpp_shr1(v[2]), dpp_shr1(v[3])}; }
__device__ __forceinline__ f32x4 ror1_4(const f32x4 v) { return (f32x4){dpp_ror1(v[0]), dpp_ror1(v[1]), dpp_ror1(v[2]), dpp_ror1(v[3])}; }
__device__ __forceinline__ f32x4 ror2_4(const f32x4 v) { return (f32x4){dpp_ror2(v[0]), dpp_ror2(v[1]), dpp_ror2(v[2]), dpp_ror2(v[3])}; }
__device__ __forceinline__ f32x4 gelu4(const f32x4 v) { return (f32x4){gelu_t(v[0]), gelu_t(v[1]), gelu_t(v[2]), gelu_t(v[3])}; }
struct EpiIn {
    static constexpr bool PERM = true;
    const ss_t* ss; bf16_t* XC; bf16_t* GG; bf16_t* A2; float* HB4; const float* cw; const float* cb;
    __device__ __forceinline__ void operator()(EPI_ARGS) const {
        const int pn = u.pn;
        if (pn < 5) {
#pragma unroll
            for (int bj = 0; bj < 2; ++bj)
#pragma unroll
                for (int n = 0; n < 2; ++n) { const int c = pn * 256 + bj * 128 + wc * 32 + 8 * fq + 4 * n;
                    const f32x4 w0 = *(const f32x4*)(cw + c), w1 = *(const f32x4*)(cw + LW + c), w2 = *(const f32x4*)(cw + 2 * LW + c), w3 = *(const f32x4*)(cw + 3 * LW + c), bb = *(const f32x4*)(cb + c);
#pragma unroll
                    for (int ai = 0; ai < 2; ++ai) { const int rowb = u.pm * 256 + ai * 128 + wr * 64 + 4 * fr; f32x4 v[4];
#pragma unroll
                        for (int m = 0; m < 4; ++m) v[m] = acc[ai][bj][m][n] * rstd_of(ss[rowb + m]);
                        const int blk = u.pm * 4 + ai * 2 + wr;
                        if (fr == 0) { float* hp = HB4 + (size_t)blk * 6 * LW + c; *(f32x4*)hp = v[0]; *(f32x4*)(hp + LW) = v[1]; *(f32x4*)(hp + 2 * LW) = v[2]; }
                        if (fr == 15) { float* hp = HB4 + ((size_t)blk * 6 + 3) * LW + c; *(f32x4*)hp = v[1]; *(f32x4*)(hp + LW) = v[2]; *(f32x4*)(hp + 2 * LW) = v[3]; }
                        const f32x4 l1 = shr1_4(v[1]), l2 = shr1_4(v[2]), l3 = shr1_4(v[3]);
                        f32x4 o[4];
                        o[0] = bb + w0 * l1 + w1 * l2 + w2 * l3 + w3 * v[0];
                        o[1] = bb + w0 * l2 + w1 * l3 + w2 * v[0] + w3 * v[1];
                        o[2] = bb + w0 * l3 + w1 * v[0] + w2 * v[1] + w3 * v[2];
                        o[3] = bb + w0 * v[0] + w1 * v[1] + w2 * v[2] + w3 * v[3];
#pragma unroll
                        for (int m = 0; m < 4; ++m) { u32x2 w; w.x = pk_bf(o[m][0], o[m][1]); w.y = pk_bf(o[m][2], o[m][3]); *(u32x2*)(XC + (size_t)(rowb + m) * LW + c) = w; }
                        asm volatile("" ::: "memory"); } }
            return; }
        ROW_LOOP { const int row = u.pm * 256 + ai * 128 + wr * 64 + 4 * fr + m; const float rs = rstd_of(ss[row]);
#pragma unroll
            for (int bj = 0; bj < 2; ++bj) { const int col = pn * 256 + bj * 128 + wc * 32 + 8 * fq; float v[8]; get8(acc, ai, bj, m, v);
#pragma unroll
                for (int j = 0; j < 8; ++j) v[j] *= rs;
                if (pn < 10) {
#pragma unroll
                    for (int j = 0; j < 8; ++j) v[j] = gelu_t(v[j]);
                    *(u32x4*)(GG + (size_t)row * LW + (col - LW)) = pack8(v); }
                else { const int cc = col - 2 * LW, gi = cc >> 4, c16 = cc & 15;
                    *(u32x4*)(A2 + (size_t)(row >> 4) * A2LD + gi * 384 + (row & 15) * 16 + c16) = pack8(v); } } }
    }
};
template <> struct RowPerm<EpiIn> { static constexpr bool value = true; };
struct EpiG1 {
    static constexpr bool PERM = true;
    bf16_t* A2;
    __device__ __forceinline__ void operator()(EPI_ARGS) const {
        ROW_LOOP { const int r = u.pm * 256 + ai * 128 + wr * 64 + m * 16 + fr; float v[8]; get8(acc, ai, 0, m, v);
            *(u32x4*)(A2 + (size_t)r * A2LD + u.pn * 384 + 256 + wc * 32 + 8 * fq) = pack8(v); }
    }
};
struct EpiGate {
    static constexpr bool PERM = true;
    bf16_t* XC; bf16_t* UU; const float* gxb; const float* gab; const float* c8t;
    __device__ __forceinline__ void operator()(EPI_ARGS) const {
        const int ch0 = u.pn * 128 + wc * 32 + 8 * fq;
        ROW_LOOP { const int row = u.pm * 256 + ai * 128 + wr * 64 + m * 16 + fr; bf16_t* xp = XC + (size_t)row * LW + ch0;
            float xc[8], gx[8], ga[8]; unpack8(*(const u32x4*)xp, xc); get8(acc, ai, 0, m, gx); get8(acc, ai, 1, m, ga);
            const f32x4 bx0 = *(const f32x4*)(gxb + ch0), bx1 = *(const f32x4*)(gxb + ch0 + 4), ba0 = *(const f32x4*)(gab + ch0), ba1 = *(const f32x4*)(gab + ch0 + 4);
            const f32x4 c80 = *(const f32x4*)(c8t + ch0), c81 = *(const f32x4*)(c8t + ch0 + 4);
            float la[8], uu[8];
#pragma unroll
            for (int j = 0; j < 8; ++j) { const float bxj = j < 4 ? bx0[j & 3] : bx1[j & 3], baj = j < 4 ? ba0[j & 3] : ba1[j & 3], c8j = j < 4 ? c80[j & 3] : c81[j & 3];
                const float sx = sigmoidf_(gx[j] + bxj), sa = sigmoidf_(ga[j] + baj); la[j] = c8j * sa;
                const float x2 = 2.0f * la[j];
                const float pl = 1.0f + x2 * (0.5f + x2 * (0.16666667f + x2 * (0.041666667f + x2 * (0.0083333333f + x2 * 0.0013888889f))));
                const float m2 = x2 > -0.5f ? -x2 * pl : 1.0f - __builtin_amdgcn_exp2f(1.44269504f * x2);
                const float mult = __builtin_amdgcn_sqrtf(fmaxf(m2, 1e-12f)); uu[j] = mult * sx * xc[j]; }
            u32x4 w; w.x = pk_h(la[0], la[1]); w.y = pk_h(la[2], la[3]); w.z = pk_h(la[4], la[5]); w.w = pk_h(la[6], la[7]);
            *(u32x4*)xp = w; *(u32x4*)(UU + (size_t)row * LW + ch0) = pack8(uu);
            if (m == 3) asm volatile("" ::: "memory"); }
    }
};
struct EpiG2 {
    static constexpr bool PERM = true;
    bf16_t* A2; const float* dd;
    __device__ __forceinline__ void operator()(EPI_ARGS) const {
        const int c0 = (8 * fq) & 15; float dv[8];
#pragma unroll
        for (int j = 0; j < 8; ++j) dv[j] = dd[u.pn * 16 + c0 + j];
        ROW_LOOP { const int r = u.pm * 256 + ai * 128 + wr * 64 + m * 16 + fr;
#pragma unroll
            for (int bj = 0; bj < 2; ++bj) { const int col = bj * 128 + wc * 32 + 8 * fq; bf16_t* p = A2 + (size_t)r * A2LD + u.pn * 384 + col;
                float v[8], uv[8]; get8(acc, ai, bj, m, v); unpack8(*(const u32x4*)p, uv);
#pragma unroll
                for (int j = 0; j < 8; ++j) v[j] = gelu_t(v[j] + dv[j] * uv[j]);
                *(u32x4*)p = pack8(v); }
            if (m == 3) asm volatile("" ::: "memory"); }
    }
};
struct EpiGlu {
    static constexpr bool PERM = true;
    bf16_t* YB; const float* bias;
    __device__ __forceinline__ void operator()(EPI_ARGS) const {
        const int oc = u.pn * 128 + wc * 32 + 8 * fq; float b0[8], b1[8];
#pragma unroll
        for (int j = 0; j < 8; ++j) { b0[j] = bias[oc + j]; b1[j] = bias[D + oc + j]; }
        ROW_LOOP { const int row = u.pm * 256 + ai * 128 + wr * 64 + m * 16 + fr; float a[8], b[8]; get8(acc, ai, 0, m, a); get8(acc, ai, 1, m, b);
#pragma unroll
            for (int j = 0; j < 8; ++j) a[j] = (a[j] + b0[j]) * sigmoidf_(b[j] + b1[j]);
            *(u32x4*)(YB + (size_t)row * D + oc) = pack8(a); }
    }
};
struct EpiBf {
    static constexpr bool PERM = true;
    bf16_t* O; int ldo; const ss_t* ss;
    __device__ __forceinline__ void operator()(EPI_ARGS) const {
        ROW_LOOP { const int row = u.pm * 256 + ai * 128 + wr * 64 + m * 16 + fr; const float rs = ss ? rstd_of(ss[row]) : 1.0f;
#pragma unroll
            for (int bj = 0; bj < 2; ++bj) { float v[8]; get8(acc, ai, bj, m, v);
#pragma unroll
                for (int j = 0; j < 8; ++j) v[j] *= rs;
                *(u32x4*)(O + (size_t)row * ldo + u.pn * 256 + bj * 128 + wc * 32 + 8 * fq) = pack8(v); } }
    }
};

struct EpiUp {
    static constexpr bool PERM = true;
    const ss_t* ss; bf16_t* H; float* HB; const float* cw; const float* cb;
    __device__ __forceinline__ void operator()(EPI_ARGS) const {
        const int cbase = u.pn * 128 + wc * 32 + 8 * fq;
#pragma unroll
        for (int n = 0; n < 2; ++n) { const int c = cbase + 4 * n;
            const f32x4 wa0 = *(const f32x4*)(cw + c), wa1 = *(const f32x4*)(cw + 2 * DFF + c), wa2 = *(const f32x4*)(cw + 4 * DFF + c), ba = *(const f32x4*)(cb + c);
            const f32x4 wb0 = *(const f32x4*)(cw + DFF + c), wb1 = *(const f32x4*)(cw + 3 * DFF + c), wb2 = *(const f32x4*)(cw + 5 * DFF + c), bb = *(const f32x4*)(cb + DFF + c);
#pragma unroll
            for (int ai = 0; ai < 2; ++ai) { const int rowb = u.pm * 256 + ai * 128 + wr * 64 + 4 * fr; f32x4 va[4], vb[4];
#pragma unroll
                for (int m = 0; m < 4; ++m) { const float rs = rstd_of(ss[rowb + m]); va[m] = acc[ai][0][m][n] * rs; vb[m] = acc[ai][1][m][n] * rs; }
                const int blk = u.pm * 4 + ai * 2 + wr;
                if (fr == 0) { float* hp = HB + (size_t)blk * 4 * (2 * DFF) + c; *(f32x4*)hp = va[0]; *(f32x4*)(hp + DFF) = vb[0]; *(f32x4*)(hp + 2 * DFF) = va[1]; *(f32x4*)(hp + 3 * DFF) = vb[1]; }
                if (fr == 15) { float* hp = HB + ((size_t)blk * 4 + 2) * (2 * DFF) + c; *(f32x4*)hp = va[2]; *(f32x4*)(hp + DFF) = vb[2]; *(f32x4*)(hp + 2 * DFF) = va[3]; *(f32x4*)(hp + 3 * DFF) = vb[3]; }
                const f32x4 la2 = shr1_4(va[2]), la3 = shr1_4(va[3]), lb2 = shr1_4(vb[2]), lb3 = shr1_4(vb[3]);
                f32x4 ca[4], cv[4];
                ca[0] = ba + wa0 * la2 + wa1 * la3 + wa2 * va[0];   cv[0] = bb + wb0 * lb2 + wb1 * lb3 + wb2 * vb[0];
                ca[1] = ba + wa0 * la3 + wa1 * va[0] + wa2 * va[1]; cv[1] = bb + wb0 * lb3 + wb1 * vb[0] + wb2 * vb[1];
                ca[2] = ba + wa0 * va[0] + wa1 * va[1] + wa2 * va[2]; cv[2] = bb + wb0 * vb[0] + wb1 * vb[1] + wb2 * vb[2];
                ca[3] = ba + wa0 * va[1] + wa1 * va[2] + wa2 * va[3]; cv[3] = bb + wb0 * vb[1] + wb1 * vb[2] + wb2 * vb[3];
#pragma unroll
                for (int m = 0; m < 4; ++m) { const f32x4 h = gelu4(ca[m]) * cv[m]; u32x2 w; w.x = pk_bf(h[0], h[1]); w.y = pk_bf(h[2], h[3]);
                    *(u32x2*)(H + (size_t)(rowb + m) * DFF + c) = w; }
                asm volatile("" ::: "memory"); } }
    }
};
template <> struct RowPerm<EpiUp> { static constexpr bool value = true; };
struct EpiMerge {
    static constexpr bool PERM = true;
    const ss_t* ss; bf16_t* YA; const bf16_t* YB;
    __device__ __forceinline__ void operator()(EPI_ARGS) const {
        const int oc = u.pn * 128 + wc * 32 + 8 * fq;
        ROW_LOOP { const int row = u.pm * 256 + ai * 128 + wr * 64 + m * 16 + fr; const float rs = rstd_of(ss[row]);
            float a[8], b[8], ya[8], yb[8]; get8(acc, ai, 0, m, a); get8(acc, ai, 1, m, b);
            unpack8(*(const u32x4*)(YA + (size_t)row * D + oc), ya); unpack8(*(const u32x4*)(YB + (size_t)row * D + oc), yb);
#pragma unroll
            for (int j = 0; j < 8; ++j) a[j] = sigmoidf_(rs * a[j]) * ya[j] + sigmoidf_(rs * b[j]) * yb[j];
            *(u32x4*)(YA + (size_t)row * D + oc) = pack8(a); }
    }
};
template <int MODE> struct EpiRes {
    static constexpr bool PERM = true;
    const float* x32; float* X; const bf16_t* XBin; bf16_t* XBout; ss_t* ss_out; const ss_t* ss_in; const bf16_t* PP;
    __device__ __forceinline__ void operator()(EPI_ARGS) const {
        ROW_LOOP { const int row = u.pm * 256 + ai * 128 + wr * 64 + m * 16 + fr; float rs = 1.0f; if (MODE != 0) rs = rstd_of(ss_in[row]);
            float q = 0.f;
#pragma unroll
            for (int bj = 0; bj < 2; ++bj) { const size_t off = (size_t)row * D + u.pn * 256 + bj * 128 + wc * 32 + 8 * fq;
                float a[8], xv[8]; get8(acc, ai, bj, m, a);
                if (MODE == 0 && x32) { const f32x4 x0 = *(const f32x4*)(x32 + off), x1 = *(const f32x4*)(x32 + off + 4); xv[0] = x0[0]; xv[1] = x0[1]; xv[2] = x0[2]; xv[3] = x0[3]; xv[4] = x1[0]; xv[5] = x1[1]; xv[6] = x1[2]; xv[7] = x1[3]; }
                else unpack8(*(const u32x4*)(XBin + off), xv);
                if (MODE != 0) { float pp[8]; unpack8(*(const u32x4*)(PP + off), pp);
#pragma unroll
                    for (int j = 0; j < 8; ++j) a[j] = sigmoidf_(rs * a[j]) * pp[j]; }
#pragma unroll
                for (int j = 0; j < 8; ++j) a[j] += xv[j];
                if (MODE != 1) { const u32x4 w = pack8(a); *(u32x4*)(XBout + off) = w; unpack8(w, a); }
                else { *(f32x4*)(X + off) = (f32x4){a[0], a[1], a[2], a[3]}; *(f32x4*)(X + off + 4) = (f32x4){a[4], a[5], a[6], a[7]}; }
#pragma unroll
                for (int j = 0; j < 8; ++j) q += a[j] * a[j]; }
            q += __shfl_xor(q, 16); q += __shfl_xor(q, 32);
            if (fq == 0) atomicAdd(ss_out + row, ss_fix(q));
            if (m == 3) asm volatile("" ::: "memory"); }
    }
};

struct Params { const float* in[32]; float* out; unsigned char* ws; };
enum { I_X = 0, I_P, I_GMIX, I_WIN, I_CAW, I_CAB, I_GXW, I_GXB, I_GAW, I_GAB, I_LAM, I_WAO, I_SARE, I_SAIM, I_SLDT, I_SBRE, I_SBIM, I_SCRE, I_SCIM, I_SD,
       I_WGLU, I_BGLU, I_WO, I_GFFN, I_WUP, I_CFW, I_CFB, I_WDN, I_GPLE, I_WPG, I_WPP, I_GFIN };

constexpr int TBL_OFF = 131072 + 4096;
struct Ctx { unsigned char* ws_; float* out_; LAS unsigned char* lds; int wid;
    __device__ __forceinline__ int tid() const { int lane; asm volatile("v_mbcnt_lo_u32_b32 %0, -1, 0\n\tv_mbcnt_hi_u32_b32 %0, -1, %0" : "=v"(lane)); return wid * 64 + lane; }
    __device__ __forceinline__ unsigned char* wsl() const { unsigned char* w = ws_; asm volatile("" : "+s"(w)); return w; }
    __device__ __forceinline__ float* outl() const { float* w = out_; asm volatile("" : "+s"(w)); return w; }
    __device__ __forceinline__ const float* in(int i) const { unsigned off = TBL_OFF + 8 * i; asm volatile("" : "+s"(off)); const LAS unsigned* t = (const LAS unsigned*)(lds + off);
        const unsigned lo = __builtin_amdgcn_readfirstlane(t[0]), hi = __builtin_amdgcn_readfirstlane(t[1]); return (const float*)(((unsigned long long)hi << 32) | lo); } };
__device__ __forceinline__ void tr_item(const float* src, int ldn, int k0, int c0, const float* scale, bf16_t* dst, int ldk, int drow0, int dk0, LAS unsigned short* s, int lane) {
    const int r4 = lane >> 4, c4 = (lane & 15) * 4;
    f32x4 v[16];
#pragma unroll
    for (int i = 0; i < 16; ++i) v[i] = *(const f32x4*)(src + (size_t)(k0 + i * 4 + r4) * ldn + c0 + c4);
#pragma unroll
    for (int i = 0; i < 16; ++i) { const int row = i * 4 + r4; f32x4 x = v[i]; if (scale) x = x * scale[k0 + row];
        s[(c4 + 0) * 66 + row] = f2bf(x[0]); s[(c4 + 1) * 66 + row] = f2bf(x[1]); s[(c4 + 2) * 66 + row] = f2bf(x[2]); s[(c4 + 3) * 66 + row] = f2bf(x[3]); }
    asm volatile("s_waitcnt lgkmcnt(0)" ::: "memory");
#pragma unroll 8
    for (int r = 0; r < 32; ++r) { const int n = r * 2 + (lane >> 5), kk = lane & 31; const unsigned w = *(const LAS unsigned*)(s + n * 66 + kk * 2);
        *(unsigned*)(dst + (size_t)(drow0 + n) * ldk + dk0 + kk * 2) = w; }
    asm volatile("s_waitcnt lgkmcnt(0)" ::: "memory");
}

__device__ __forceinline__ void s5_lam(float are, float aim, float dt, float pw, float& re, float& im) { const float mag = expf(are * dt * pw); float rev = aim * dt * pw * 0.15915494309f; rev -= floorf(rev);
    re = mag * __builtin_amdgcn_cosf(rev); im = mag * __builtin_amdgcn_sinf(rev); }
__device__ __forceinline__ void s5_coef(float are, float aim, float dt, float& cre, float& cim) {
    float lr, li; s5_lam(are, aim, dt, 1.0f, lr, li); const float nr = lr - 1.0f, ni = li, den = are * are + aim * aim;
    cre = (nr * are + ni * aim) / den; cim = (ni * are - nr * aim) / den;
}

__device__ __forceinline__ void phase0(const Ctx& P, int l, LAS unsigned char* lds) {
    int tid_ = P.tid(); asm volatile("" : "+v"(tid_));
    const int tid = tid_, lane = tid & 63, wave = tid >> 6;
    const int gw = bidx() * NWAVES + wave, NGW = gdim() * NWAVES;
    const int gt = bidx() * NTHREADS + tid, NGT = gdim() * NTHREADS;
    unsigned char* ws = P.wsl(); bf16_t* W = (bf16_t*)(ws + WS_W);
    LAS unsigned short* scr = (LAS unsigned short*)(lds + wave * 16384);
    const float* gmix = P.in(I_GMIX) + l * D; const float* gffn = P.in(I_GFFN) + l * D; const float* gple = P.in(I_GPLE) + l * D;
    const float* win = P.in(I_WIN) + (size_t)l * D * NIN;
    constexpr int C0 = 16 * 56, C1 = 16 * 32, C2 = 20 * 16, C3 = 16 * 32, C4 = 256, C5 = 16 * 96, C6 = 48 * 16, C7 = 256, C8 = 4 * 16, C9 = 80;
    constexpr int CT = C0 + C1 + C2 + C3 + C4 + C5 + C6 + C7 + C8 + C9;
    for (int item = gw; item < CT; item += NGW) {
        int it = item;
        if (it < C0) { const int kb = it % 16, nb = it / 16; tr_item(win, NIN, kb * 64, nb * 64, gmix, W + W_IN, D, nb * 64, kb * 64, scr, lane); continue; } it -= C0;
        if (it < C1) { const int kb = it % 16, nb = it / 16, n0 = nb * 64, c0 = 3584 + ((n0 >> 7) & 1) * 1024 + (n0 >> 8) * 128 + (n0 & 127);
            tr_item(win, NIN, kb * 64, c0, gmix, W + W_MG, D, n0, kb * 64, scr, lane); continue; } it -= C1;
        if (it < C2) { const int kb = it % 20, nb = it / 20; tr_item(P.in(I_WAO) + (size_t)l * LW * D, D, kb * 64, nb * 64, nullptr, W + W_AO, LW, nb * 64, kb * 64, scr, lane); continue; } it -= C2;
        if (it < C3) { const int kb = it % 16, nb = it / 16, n0 = nb * 64, c0 = ((n0 >> 7) & 1) * 1024 + (n0 >> 8) * 128 + (n0 & 127);
            tr_item(P.in(I_WGLU) + (size_t)l * D * 2 * D, 2 * D, kb * 64, c0, nullptr, W + W_GLU, D, n0, kb * 64, scr, lane); continue; } it -= C3;
        if (it < C4) { const int kb = it % 16, nb = it / 16; tr_item(P.in(I_WO) + (size_t)l * D * D, D, kb * 64, nb * 64, nullptr, W + W_O, D, nb * 64, kb * 64, scr, lane); continue; } it -= C4;
        if (it < C5) { const int kb = it % 16, nb = it / 16, n0 = nb * 64, c0 = ((n0 >> 7) & 1) * DFF + (n0 >> 8) * 128 + (n0 & 127);
            tr_item(P.in(I_WUP) + (size_t)l * D * 2 * DFF, 2 * DFF, kb * 64, c0, gffn, W + W_UP, D, n0, kb * 64, scr, lane); continue; } it -= C5;
        if (it < C6) { const int kb = it % 48, nb = it / 48; tr_item(P.in(I_WDN) + (size_t)l * DFF * D, D, kb * 64, nb * 64, nullptr, W + W_DN, DFF, nb * 64, kb * 64, scr, lane); continue; } it -= C6;
        if (it < C7) { const int kb = it % 16, nb = it / 16; tr_item(P.in(I_WPG) + (size_t)l * D * D, D, kb * 64, nb * 64, gple, W + W_PG, D, nb * 64, kb * 64, scr, lane); continue; } it -= C7;
        if (it < C8) { const int kb = it % 4, nb = it / 4; tr_item(P.in(I_WPP) + (size_t)l * PLE * D, D, kb * 64, nb * 64, nullptr, W + W_PP, PLE, nb * 64, kb * 64, scr, lane); continue; } it -= C8;
        { const int j = it >> 2, h = j >> 1, bj = j & 1, sub = it & 3, kb = sub & 1, nb = sub >> 1;
          const float* src = (bj ? P.in(I_GAW) : P.in(I_GXW)) + (size_t)(l * 10 + h) * 128 * 128;
          tr_item(src, 128, kb * 64, nb * 64, nullptr, W + W_GATE, 128, h * 256 + bj * 128 + nb * 64, kb * 64, scr, lane); }
    }
    { float* c8 = (float*)(ws + WS_C8); const float* lam = P.in(I_LAM) + l * LW; for (int i = gt; i < LW; i += NGT) c8[i] = -8.0f * log1pf(__expf(-lam[i])); }
    const float* are = P.in(I_SARE) + l * 4096; const float* aim = P.in(I_SAIM) + l * 4096; const float* ldt = P.in(I_SLDT) + l * 64;
    const float* bre = P.in(I_SBRE) + (size_t)l * 65536; const float* bim = P.in(I_SBIM) + (size_t)l * 65536;
    const float* cre = P.in(I_SCRE) + (size_t)l * 65536; const float* cim = P.in(I_SCIM) + (size_t)l * 65536;
    float* KD = (float*)(ws + WS_KD);
    for (int i = (wave * gdim() + bidx()) * 64 + lane; i < 64 * 16 * 16 * 4; i += NGT) { const int pq = i & 3, co = (i >> 2) & 15, d = (i >> 6) & 15, g = i >> 10; const float dt = expf(ldt[g]);
        float a16[16];
#pragma unroll
        for (int c = 0; c < 16; ++c) a16[c] = 0.f;
#pragma unroll 4
        for (int pp = 0; pp < 16; ++pp) { const int p = pq * 16 + pp; const float ar = are[g * 64 + p], ai = aim[g * 64 + p]; float lr, li, kr, ki; s5_lam(ar, ai, dt, (float)d, lr, li); s5_coef(ar, ai, dt, kr, ki);
            const float cr = cre[(g * 16 + co) * 64 + p], ci = cim[(g * 16 + co) * 64 + p];
            const float t_r = cr * lr - ci * li, t_i = cr * li + ci * lr; const float w_r = t_r * kr - t_i * ki, w_i = t_r * ki + t_i * kr;
            const float* br = bre + (size_t)(g * 64 + p) * 16; const float* bi = bim + (size_t)(g * 64 + p) * 16;
#pragma unroll
            for (int c = 0; c < 16; ++c) a16[c] += w_r * br[c] - w_i * bi[c]; }
#pragma unroll
        for (int c = 0; c < 16; ++c) { a16[c] += __shfl_xor(a16[c], 1); a16[c] += __shfl_xor(a16[c], 2); }
        if (pq == 0) {
#pragma unroll
            for (int c = 0; c < 16; ++c) KD[(size_t)(i >> 2) * 16 + c] = a16[c]; } }
    for (int i = gt; i < 64 * 256 * 16; i += NGT) { const int j = i & 15, n = (i >> 4) & 255, g = i >> 12; bf16_t* dst = W + W_T1 + ((size_t)(g * 256 + n) * 256 + j * 16);
        float v[16];
        if (n < 128) { const int p = n & 63; const float dt = expf(ldt[g]), ar = are[g * 64 + p], ai = aim[g * 64 + p]; float lr, li, kr, ki; s5_lam(ar, ai, dt, (float)(15 - j), lr, li); s5_coef(ar, ai, dt, kr, ki);
            const float w_r = lr * kr - li * ki, w_i = lr * ki + li * kr; const float* br = bre + (size_t)(g * 64 + p) * 16; const float* bi = bim + (size_t)(g * 64 + p) * 16;
#pragma unroll
            for (int c = 0; c < 16; ++c) v[c] = (n < 64) ? (w_r * br[c] - w_i * bi[c]) : (w_r * bi[c] + w_i * br[c]); }
        else {
#pragma unroll
            for (int c = 0; c < 16; ++c) v[c] = 0.f; }
        u32x4 w0, w1; w0.x = pk_bf(v[0], v[1]); w0.y = pk_bf(v[2], v[3]); w0.z = pk_bf(v[4], v[5]); w0.w = pk_bf(v[6], v[7]); w1.x = pk_bf(v[8], v[9]); w1.y = pk_bf(v[10], v[11]); w1.z = pk_bf(v[12], v[13]); w1.w = pk_bf(v[14], v[15]);
        *(u32x4*)dst = w0; *(u32x4*)(dst + 8) = w1; }
    for (int i = gt; i < 64 * 16 * 64; i += NGT) { const int p = i & 63, t = (i >> 6) & 15, g = i >> 10; const float dt = expf(ldt[g]); float lr, li; s5_lam(are[g * 64 + p], aim[g * 64 + p], dt, (float)(t + 1), lr, li);
        for (int co = 0; co < 16; ++co) { const float cr = cre[(g * 16 + co) * 64 + p], ci = cim[(g * 16 + co) * 64 + p]; bf16_t* dst = W + W_T2 + (size_t)(g * 256 + t * 16 + co) * 384 + 256 + p;
            dst[0] = f2bf(cr * lr - ci * li); dst[64] = f2bf(-(cr * li + ci * lr)); } }
    { const float* pp = P.in(I_P) + (size_t)l * M * PLE; bf16_t* PB = (bf16_t*)(ws + WS_PB);
      for (size_t i = gt; i < (size_t)M * PLE / 8; i += (size_t)4 * NGT) { f32x4 a[4], b[4];
#pragma unroll
          for (int j = 0; j < 4; ++j) { const size_t k = i + (size_t)j * NGT; if (k < (size_t)M * PLE / 8) { a[j] = *(const f32x4*)(pp + k * 8); b[j] = *(const f32x4*)(pp + k * 8 + 4); } }
#pragma unroll
          for (int j = 0; j < 4; ++j) { const size_t k = i + (size_t)j * NGT; if (k < (size_t)M * PLE / 8) {
              u32x4 w; w.x = pk_bf(a[j][0], a[j][1]); w.y = pk_bf(a[j][2], a[j][3]); w.z = pk_bf(b[j][0], b[j][1]); w.w = pk_bf(b[j][2], b[j][3]); *(u32x4*)(PB + k * 8) = w; } } } }
    if (l == 0) {
        ss_t* SS = (ss_t*)(ws + WS_SS); bf16_t* XB = (bf16_t*)(ws + WS_XB); const float* x = P.in(I_X);
        for (int i = gt; i < 6 * M; i += NGT) SS[M + i] = 0ull;
        for (int row = gw; row < M; row += 4 * NGW) { f32x4 v[4][4];
#pragma unroll
            for (int r = 0; r < 4; ++r) { const int rr = row + r * NGW; if (rr < M) {
#pragma unroll
                for (int j = 0; j < 4; ++j) v[r][j] = *(const f32x4*)(x + (size_t)rr * D + j * 256 + lane * 4); } }
#pragma unroll
            for (int r = 0; r < 4; ++r) { const int rr = row + r * NGW; if (rr < M) { float q = 0.f;
#pragma unroll
                for (int j = 0; j < 4; ++j) { const f32x4 t = v[r][j]; q += (t[0] * t[0] + t[1] * t[1]) + (t[2] * t[2] + t[3] * t[3]);
                    u32x2 w; w.x = pk_bf(t[0], t[1]); w.y = pk_bf(t[2], t[3]); *(u32x2*)(XB + (size_t)rr * D + j * 256 + lane * 4) = w; }
                q = wave_sum(q); if (lane == 0) SS[rr] = ss_fix(q); } } }
    }
}

__device__ __forceinline__ void fill_t2(const Ctx& P) {
    int gt_ = bidx() * NTHREADS + P.tid(); asm volatile("" : "+v"(gt_)); const int gt = gt_, NGT = gdim() * NTHREADS;
    const float* KD = (const float*)(P.wsl() + WS_KD); bf16_t* W = (bf16_t*)(P.wsl() + WS_W);
    for (int i = gt; i < 64 * 256 * 16; i += NGT) { const int s = i & 15, n = (i >> 4) & 255, g = i >> 12, t = n >> 4, co = n & 15; bf16_t* dst = W + W_T2 + (size_t)(g * 256 + n) * 384 + s * 16;
        u32x4 w0 = (u32x4){0u, 0u, 0u, 0u}, w1 = w0;
        if (s <= t) { const float* k = KD + ((size_t)((g * 16 + (t - s)) * 16 + co)) * 16; const f32x4 a = *(const f32x4*)k, b = *(const f32x4*)(k + 4), c = *(const f32x4*)(k + 8), d = *(const f32x4*)(k + 12);
            w0.x = pk_bf(a[0], a[1]); w0.y = pk_bf(a[2], a[3]); w0.z = pk_bf(b[0], b[1]); w0.w = pk_bf(b[2], b[3]); w1.x = pk_bf(c[0], c[1]); w1.y = pk_bf(c[2], c[3]); w1.z = pk_bf(d[0], d[1]); w1.w = pk_bf(d[2], d[3]); }
        *(u32x4*)dst = w0; *(u32x4*)(dst + 8) = w1; }
}

__device__ __forceinline__ void fixup_xc(const Ctx& P, int l) {
    int tid_ = P.tid(); asm volatile("" : "+v"(tid_)); const int tid = tid_;
    const float* HB4 = (const float*)(P.wsl() + WS_HB4); bf16_t* XC = (bf16_t*)(P.wsl() + WS_R3);
    const float* cw = P.in(I_CAW) + (size_t)l * 4 * LW; const float* cb = P.in(I_CAB) + (size_t)l * LW;
    StaticOrder S; S.init(128, 10, gdim(), bidx()); Unit u;
    for (int ui = 0; S.next(ui, u); ++ui) {
        for (int i = tid; i < 4 * 128; i += NTHREADS) { const int bl = i >> 7, c = u.pn * 128 + (i & 127), blk = u.pm * 4 + bl; const bool first = (blk & 63) == 0;
            const float* hb = HB4 + (size_t)blk * 6 * LW + c; const float* pb = hb - 6 * LW;
            const float t3 = first ? 0.f : pb[3 * LW], t2 = first ? 0.f : pb[4 * LW], t1 = first ? 0.f : pb[5 * LW], h0 = hb[0], h1 = hb[LW], h2 = hb[2 * LW];
            const float w0 = cw[c], w1 = cw[LW + c], w2 = cw[2 * LW + c], w3 = cw[3 * LW + c], bb = cb[c];
            bf16_t* xp = XC + (size_t)blk * 64 * LW + c;
            xp[0] = f2bf(bb + w0 * t3 + w1 * t2 + w2 * t1 + w3 * h0);
            xp[LW] = f2bf(bb + w0 * t2 + w1 * t1 + w2 * h0 + w3 * h1);
            xp[2 * LW] = f2bf(bb + w0 * t1 + w1 * h0 + w2 * h1 + w3 * h2); } }
    asm volatile("s_waitcnt vmcnt(0)" ::: "memory");
    __syncthreads();
}

__device__ __forceinline__ void s5_carry(const Ctx& P, int l) {
    int tid_ = P.tid(); asm volatile("" : "+v"(tid_));
    const int tid = tid_, lane = tid & 63, wave = tid >> 6;
    for (int gwv = wave * gdim() + bidx(); gwv < 512; gwv += 2 * gdim()) {
    const int idx = gwv * 64 + lane, p = idx & 63, g = (idx >> 6) & 63, b = idx >> 12;
    const float dt = expf(P.in(I_SLDT)[l * 64 + g]); float lr, li; s5_lam(P.in(I_SARE)[l * 4096 + g * 64 + p], P.in(I_SAIM)[l * 4096 + g * 64 + p], dt, 16.0f, lr, li);
    bf16_t* base = (bf16_t*)(P.wsl() + WS_A2) + (size_t)(b * 256) * A2LD + g * 384 + 256 + p;
    float sr = 0.f, si = 0.f;
    for (int cb = 0; cb < 8; ++cb) { float er[32], ei[32];
#pragma unroll
        for (int k = 0; k < 32; ++k) { const bf16_t* q = base + (size_t)(cb * 32 + k) * A2LD; er[k] = bf2f(q[0]); ei[k] = bf2f(q[64]); }
#pragma unroll
        for (int k = 0; k < 32; ++k) { bf16_t* q = base + (size_t)(cb * 32 + k) * A2LD; q[0] = f2bf(sr); q[64] = f2bf(si);
            const float nr = lr * sr - li * si + er[k], ni = lr * si + li * sr + ei[k]; sr = nr; si = ni; } }
    }
}

__device__ __forceinline__ void lru_scan_a(const Ctx& P) {
    int gt_ = bidx() * 384 + (P.tid() - 128); asm volatile("" : "+v"(gt_)); const int gt = gt_, NGT = gdim() * 384;
    const unsigned* LA = (const unsigned*)(P.wsl() + WS_R3); const unsigned* UU = (const unsigned*)(P.wsl() + WS_R1); float4* SUM = (float4*)(P.wsl() + WS_SUM);
    for (int i = gt; i < 8 * 64 * 640; i += NGT) { const int c2 = i % 640, bk = i / 640; const size_t o = (size_t)bk * 64 * 640 + c2;
        float p0 = 1.f, p1 = 1.f, h0 = 0.f, h1 = 0.f;
        for (int tb = 0; tb < 4; ++tb) { unsigned lw[16], uw[16];
#pragma unroll
            for (int t = 0; t < 16; ++t) { lw[t] = LA[o + (size_t)(tb * 16 + t) * 640]; uw[t] = UU[o + (size_t)(tb * 16 + t) * 640]; }
#pragma unroll
            for (int t = 0; t < 16; ++t) { const h16x2 lh = __builtin_bit_cast(h16x2, lw[t]);
                const float a0 = __expf((float)lh.x), a1 = __expf((float)lh.y); h0 = a0 * h0 + lo_bf(uw[t]); h1 = a1 * h1 + hi_bf(uw[t]); p0 *= a0; p1 *= a1; } }
        SUM[i] = make_float4(p0, h0, p1, h1); }
}
__device__ __forceinline__ void lru_scan_c(const Ctx& P) {
    int gt_ = bidx() * NTHREADS + P.tid(); asm volatile("" : "+v"(gt_)); const int gt = gt_, NGT = gdim() * NTHREADS;
    const unsigned* LA = (const unsigned*)(P.wsl() + WS_R3); unsigned* UU = (unsigned*)(P.wsl() + WS_R1); const unsigned* GG = (const unsigned*)(P.wsl() + WS_R2); const float4* SUM = (const float4*)(P.wsl() + WS_SUM);
    for (int i = gt; i < 8 * 64 * 640; i += NGT) { const int c2 = i % 640, bk = i / 640, k = bk & 63, b = bk >> 6; const size_t o = (size_t)bk * 64 * 640 + c2;
        float h0 = 0.f, h1 = 0.f;
        for (int kb = 0; kb < k; kb += 8) { float4 sv[8];
#pragma unroll
            for (int j = 0; j < 8; ++j) sv[j] = (kb + j < k) ? SUM[(size_t)(b * 64 + kb + j) * 640 + c2] : make_float4(1.f, 0.f, 1.f, 0.f);
#pragma unroll
            for (int j = 0; j < 8; ++j) { h0 = sv[j].x * h0 + sv[j].y; h1 = sv[j].z * h1 + sv[j].w; } }
        for (int tb = 0; tb < 4; ++tb) { unsigned lw[16], uw[16], gw[16];
#pragma unroll
            for (int t = 0; t < 16; ++t) { const size_t a = o + (size_t)(tb * 16 + t) * 640; lw[t] = LA[a]; uw[t] = UU[a]; gw[t] = GG[a]; }
#pragma unroll
            for (int t = 0; t < 16; ++t) { const size_t a = o + (size_t)(tb * 16 + t) * 640; const h16x2 lh = __builtin_bit_cast(h16x2, lw[t]);
                const float a0 = __expf((float)lh.x), a1 = __expf((float)lh.y); h0 = a0 * h0 + lo_bf(uw[t]); h1 = a1 * h1 + hi_bf(uw[t]);
                UU[a] = pk_bf(h0 * lo_bf(gw[t]), h1 * hi_bf(gw[t])); } } }
}
__device__ __forceinline__ void fixup_h(const Ctx& P, int l) {
    int tid_ = P.tid(); asm volatile("" : "+v"(tid_)); const int tid = tid_;
    const float* HB = (const float*)(P.wsl() + WS_HB); bf16_t* H = (bf16_t*)(P.wsl() + WS_H);
    const float* cw = P.in(I_CFW) + (size_t)l * 3 * 2 * DFF; const float* cb = P.in(I_CFB) + (size_t)l * 2 * DFF;
    StaticOrder S; S.init(128, 4, gdim(), bidx()); Unit u;
    for (int ui = 0; S.next(ui, u); ++ui) {
        for (int i = tid; i < 4 * 768; i += NTHREADS) { const int bl = i / 768, c = (i - bl * 768) * 4, blk = u.pm * 4 + bl; const bool first = (blk & 63) == 0;
            const float* hb = HB + (size_t)blk * 4 * (2 * DFF) + c; const float* pb = hb - 4 * (2 * DFF);
            const f32x4 z = (f32x4){0.f, 0.f, 0.f, 0.f};
            const f32x4 a_m2 = first ? z : *(const f32x4*)(pb + 2 * (2 * DFF)), a_m1 = first ? z : *(const f32x4*)(pb + 3 * (2 * DFF)), a_0 = *(const f32x4*)hb, a_1 = *(const f32x4*)(hb + 2 * DFF);
            const f32x4 b_m2 = first ? z : *(const f32x4*)(pb + 2 * (2 * DFF) + DFF), b_m1 = first ? z : *(const f32x4*)(pb + 3 * (2 * DFF) + DFF), b_0 = *(const f32x4*)(hb + DFF), b_1 = *(const f32x4*)(hb + 2 * DFF + DFF);
            const f32x4 wa0 = *(const f32x4*)(cw + c), wa1 = *(const f32x4*)(cw + 2 * DFF + c), wa2 = *(const f32x4*)(cw + 4 * DFF + c), ba = *(const f32x4*)(cb + c);
            const f32x4 wb0 = *(const f32x4*)(cw + DFF + c), wb1 = *(const f32x4*)(cw + 3 * DFF + c), wb2 = *(const f32x4*)(cw + 5 * DFF + c), bb = *(const f32x4*)(cb + DFF + c);
            const f32x4 ca0 = ba + wa0 * a_m2 + wa1 * a_m1 + wa2 * a_0, cb0 = bb + wb0 * b_m2 + wb1 * b_m1 + wb2 * b_0;
            const f32x4 ca1 = ba + wa0 * a_m1 + wa1 * a_0 + wa2 * a_1, cb1 = bb + wb0 * b_m1 + wb1 * b_0 + wb2 * b_1;
            const f32x4 h0 = gelu4(ca0) * cb0, h1 = gelu4(ca1) * cb1; u32x2 w0, w1; w0.x = pk_bf(h0[0], h0[1]); w0.y = pk_bf(h0[2], h0[3]); w1.x = pk_bf(h1[0], h1[1]); w1.y = pk_bf(h1[2], h1[3]);
            bf16_t* hp = H + (size_t)blk * 64 * DFF + c; *(u32x2*)hp = w0; *(u32x2*)(hp + DFF) = w1; } }
    asm volatile("s_waitcnt vmcnt(0)" ::: "memory");
    __syncthreads();
}
__device__ __forceinline__ void final_norm(const Ctx& P) {
    int tid_ = P.tid(); asm volatile("" : "+v"(tid_));
    const int tid = tid_, lane = tid & 63, wave = tid >> 6; const int gw = bidx() * NWAVES + wave, NGW = gdim() * NWAVES;
    const ss_t* SS = (const ss_t*)(P.wsl() + WS_SS) + 6 * M; const float* gf = P.in(I_GFIN); float* X = P.outl();
    for (int row = gw; row < M; row += 2 * NGW) { f32x4 v[2][4]; float rs[2];
#pragma unroll
        for (int r = 0; r < 2; ++r) { const int rr = row + r * NGW; if (rr < M) { rs[r] = rstd_of(SS[rr]);
#pragma unroll
            for (int j = 0; j < 4; ++j) v[r][j] = *(const f32x4*)(X + (size_t)rr * D + j * 256 + lane * 4); } }
#pragma unroll
        for (int r = 0; r < 2; ++r) { const int rr = row + r * NGW; if (rr < M) {
#pragma unroll
            for (int j = 0; j < 4; ++j) { const f32x4 gv = *(const f32x4*)(gf + j * 256 + lane * 4); *(f32x4*)(X + (size_t)rr * D + j * 256 + lane * 4) = v[r][j] * rs[r] * gv; } } } }
}

#define XB_TMO      128
#define XB_XCNT(j)  (256  + 64 * (j))
#define XB_XSUB(j)  (1280 + 64 * (j))
#define XB_XGEN(j)  (2304 + 64 * (j))
#define XB_TOP      3328
#define XB_TOPGEN   3392
#define XCD_BAR_WORDS 3456
#define XB_SPIN_CAP (1u << 22)
__device__ __forceinline__ unsigned xb_ld(unsigned* p)              { return __hip_atomic_load(p, __ATOMIC_RELAXED, __HIP_MEMORY_SCOPE_AGENT); }
__device__ __forceinline__ unsigned xb_add(unsigned* p, unsigned v) { return __hip_atomic_fetch_add(p, v, __ATOMIC_RELAXED, __HIP_MEMORY_SCOPE_AGENT); }
__device__ __forceinline__ unsigned xb_xcc_id() { return (unsigned)__builtin_amdgcn_s_getreg((3 << 11) | 20) & 0xFu; }
#define XB_SPIN(cond, bar) do { unsigned _sp = 0; while (cond) { __builtin_amdgcn_s_sleep(1); \
    if ((++_sp & 255u) == 0u) { if (xb_ld(&(bar)[XB_TMO])) break; if (_sp > XB_SPIN_CAP) { atomicAdd(&(bar)[XB_TMO], 1u); break; } } } } while (0)
struct XcdBarrier { unsigned* bar; unsigned x; volatile LAS unsigned* st; };
__device__ __forceinline__ XcdBarrier xcd_barrier_post(unsigned* bar, volatile LAS unsigned* st) {
    XcdBarrier b; b.bar = bar; b.x = xb_xcc_id(); b.st = st;
    if (threadIdx.x == 0) (void)xb_add(&bar[XB_XCNT(b.x)], 1u);
    return b;
}
__device__ __forceinline__ void xcd_barrier_complete(unsigned* bar, unsigned x_, unsigned& nloc, unsigned& nx) {
    unsigned x = x_;
    const unsigned G = gridDim.x * gridDim.y * gridDim.z;
    asm volatile("" : "+s"(x));
    unsigned sum, cnt, mine, sp = 0u;
    for (;;) {
        sum = 0u; cnt = 0u; mine = 0u;
#pragma unroll
        for (unsigned j = 0; j < 16; ++j) { const unsigned c = xb_ld(&bar[XB_XCNT(j)]); sum += c; cnt += (c > 0u) ? 1u : 0u; mine = (j == x) ? c : mine; }
        if (sum == G) break;
        __builtin_amdgcn_s_sleep(1);
        if ((++sp & 255u) == 0u) { if (xb_ld(&bar[XB_TMO])) break; if (sp > XB_SPIN_CAP) { atomicAdd(&bar[XB_TMO], 1u); break; } }
    }
    nloc = mine > 0u ? mine : 1u; nx = cnt > 0u ? cnt : 1u;
}
__device__ __forceinline__ void xcd_barrier(const XcdBarrier& b, int tid) {
    asm volatile("s_waitcnt vmcnt(0)" ::: "memory");
    __syncthreads();
    if (tid == 0) {
        unsigned* bar = b.bar;
        __builtin_amdgcn_s_waitcnt(0);
        unsigned nloc = b.st[0], nx = b.st[1];
        if (nloc == 0u) { xcd_barrier_complete(bar, b.x, nloc, nx); b.st[0] = nloc; b.st[1] = nx; }
        const unsigned old = xb_add(&bar[XB_XSUB(b.x)], 1u);
        const unsigned gen = old / nloc;
        if (old + 1u == (gen + 1u) * nloc) {
            __builtin_amdgcn_fence(__ATOMIC_RELEASE, "agent");
            asm volatile("s_waitcnt vmcnt(0)" ::: "memory");
            const unsigned og = xb_add(&bar[XB_TOP], 1u);
            const unsigned tg = og / nx;
            if (og + 1u == (tg + 1u) * nx) xb_add(&bar[XB_TOPGEN], 1u);
            else XB_SPIN(xb_ld(&bar[XB_TOPGEN]) == tg, bar);
            __builtin_amdgcn_fence(__ATOMIC_ACQUIRE, "agent");
            xb_add(&bar[XB_XGEN(b.x)], 1u);
            asm volatile("s_waitcnt vmcnt(0)" ::: "memory");
        } else {
            XB_SPIN(xb_ld(&bar[XB_XGEN(b.x)]) == gen, bar);
            __builtin_amdgcn_fence(__ATOMIC_ACQUIRE, "agent");
            asm volatile("s_waitcnt vmcnt(0)" ::: "memory");
        }
    }
    __syncthreads();
}

#define WSB(off) ((bf16_t*)(P.wsl() + (off)))
#define SSP(k) ((ss_t*)(P.wsl() + WS_SS) + (size_t)(k) * M)
#define gemm_phase(lds_, g_, E_) gemm_phase_t(lds_, g_, E_, P.tid())
#define SYNC() do { xcd_barrier(xbar, P.tid()); } while (0)
#define SYNC_CG() do { __syncthreads(); grid.sync(); } while (0)
template <int l> __device__ __forceinline__ void layer_fwd(const Ctx& P, LAS unsigned char* lds, cg::grid_group& grid, const XcdBarrier& xbar) {


        phase0(P, l, lds);
        if (l == 0 && P.ws_ == nullptr) SYNC_CG();
        SYNC();
#define XBL ((l == 0) ? WSB(WS_XB) : (bf16_t*)P.outl())
        { Gemm g = mk_gemm(XBL, D, WSB(WS_W) + W_IN, D, 128, 14);
          EpiIn E{SSP(3 * l), WSB(WS_R3), WSB(WS_R2), WSB(WS_A2), (float*)(P.wsl() + WS_HB4), P.in(I_CAW) + (size_t)l * 4 * LW, P.in(I_CAB) + (size_t)l * LW}; gemm_phase(lds, g, E); }
        SYNC();
        { Gemm g = mk_gemm(WSB(WS_A2), A2LD, WSB(WS_W) + W_T1, 256, 8, 64); g.a_pn_bytes = 768; EpiG1 E{WSB(WS_A2)}; gemm_phase(lds, g, E); }
        fill_t2(P);
        fixup_xc(P, l);
        { Gemm g = mk_gemm(WSB(WS_R3), LW, WSB(WS_W) + W_GATE, 128, 128, 10); g.a_pn_bytes = 256;
          EpiGate E{WSB(WS_R3), WSB(WS_R1), P.in(I_GXB) + l * LW, P.in(I_GAB) + l * LW, (const float*)(P.wsl() + WS_C8)}; gemm_phase(lds, g, E); }
        SYNC();
        if (P.wid < 2) s5_carry(P, l); else lru_scan_a(P);
        SYNC();
        for (int sb = 0; sb < 2; ++sb) {
            if ((sb ^ (bidx() & 1)) == 0) lru_scan_c(P);
            else { Gemm g = mk_gemm(WSB(WS_A2), A2LD, WSB(WS_W) + W_T2, 384, 8, 64); g.a_pn_bytes = 768; EpiG2 E{WSB(WS_A2), P.in(I_SD) + l * D}; gemm_phase(lds, g, E); }
            __syncthreads(); }
        SYNC();
        for (int sb = 0; sb < 2; ++sb) {
            if ((sb ^ (bidx() & 1)) == 0) { Gemm g = mk_gemm(WSB(WS_A2), 0, WSB(WS_W) + W_GLU, D, 128, 8); g.a_packed = 1; g.a_tstep = (long)16 * A2LD * 2; g.a_hstep = (long)8 * A2LD * 2; g.a_kstep = 1536 * 2;
                EpiGlu E{WSB(WS_R3), P.in(I_BGLU) + l * 2 * D}; gemm_phase(lds, g, E); }
            else { Gemm g = mk_gemm(WSB(WS_R1), LW, WSB(WS_W) + W_AO, LW, 128, 4); EpiBf E{WSB(WS_R2), D, nullptr}; gemm_phase(lds, g, E); }
            __syncthreads(); }
        SYNC();
        { Gemm g = mk_gemm(XBL, D, WSB(WS_W) + W_MG, D, 128, 8); EpiMerge E{SSP(3 * l), WSB(WS_R2), WSB(WS_R3)}; gemm_phase(lds, g, E); }
        SYNC();
        { Gemm g = mk_gemm(WSB(WS_R2), D, WSB(WS_W) + W_O, D, 128, 4); EpiRes<0> E{l == 0 ? P.in(I_X) : nullptr, nullptr, XBL, WSB(WS_XB), SSP(3 * l + 1), nullptr, nullptr}; gemm_phase(lds, g, E); }
        SYNC();
        for (int sb = 0; sb < 2; ++sb) {
            if ((sb ^ (bidx() & 1)) == 0) { Gemm g = mk_gemm(WSB(WS_XB), D, WSB(WS_W) + W_UP, D, 128, 24);
                EpiUp E{SSP(3 * l + 1), WSB(WS_H), (float*)(P.wsl() + WS_HB), P.in(I_CFW) + (size_t)l * 3 * 2 * DFF, P.in(I_CFB) + (size_t)l * 2 * DFF}; gemm_phase(lds, g, E); }
            else { Gemm g = mk_gemm(WSB(WS_PB), PLE, WSB(WS_W) + W_PP, PLE, 128, 4); EpiBf E{WSB(WS_PP), D, nullptr}; gemm_phase(lds, g, E); }
            __syncthreads(); }
        SYNC();
        fixup_h(P, l);
        { Gemm g = mk_gemm(WSB(WS_H), DFF, WSB(WS_W) + W_DN, DFF, 128, 4);
          EpiRes<0> E{nullptr, nullptr, WSB(WS_XB), WSB(WS_XB), SSP(3 * l + 2), nullptr, nullptr}; gemm_phase(lds, g, E); }
        SYNC();
        { Gemm g = mk_gemm(WSB(WS_XB), D, WSB(WS_W) + W_PG, D, 128, 4);
          if (l == DEPTH - 1) { EpiRes<1> E{nullptr, P.outl(), WSB(WS_XB), nullptr, SSP(3 * l + 3), SSP(3 * l + 2), WSB(WS_PP)}; gemm_phase(lds, g, E); }
          else { EpiRes<2> E{nullptr, nullptr, WSB(WS_XB), (bf16_t*)P.outl(), SSP(3 * l + 3), SSP(3 * l + 2), WSB(WS_PP)}; gemm_phase(lds, g, E); } }
        SYNC();
    }

__global__ void __launch_bounds__(NTHREADS, 2) fwd_kernel(Params KP) {
    extern __shared__ __attribute__((aligned(16))) unsigned char lds_raw[];
    LAS unsigned char* lds = (LAS unsigned char*)lds_raw;
    cg::grid_group grid = cg::this_grid();
    if (threadIdx.x == 0) { LAS unsigned long long* t = (LAS unsigned long long*)(lds + TBL_OFF);
#pragma unroll
        for (int i = 0; i < 32; ++i) t[i] = (unsigned long long)KP.in[i]; }
    if (threadIdx.x < 4) ((LAS unsigned*)(lds + TBL_OFF + 512))[threadIdx.x] = 0u;
    __syncthreads();
    Ctx P; P.ws_ = KP.ws; P.out_ = KP.out; P.lds = lds; P.wid = __builtin_amdgcn_readfirstlane(threadIdx.x >> 6);
    XcdBarrier xbar = xcd_barrier_post((unsigned*)(KP.ws + WS_BAR), (volatile LAS unsigned*)(lds + TBL_OFF + 512));
    layer_fwd<0>(P, lds, grid, xbar);
    layer_fwd<1>(P, lds, grid, xbar);
    final_norm(P);
}

extern "C" void kernel_launch(void* const* d_in, const int* in_sizes, int n_in, void* d_out, int out_size, void* d_ws, size_t ws_size, hipStream_t stream) {
    static int grid = 0;
    if (grid == 0) {
        int dev = 0, cus = 0, per_cu = 0;
        (void)hipGetDevice(&dev); (void)hipDeviceGetAttribute(&cus, hipDeviceAttributeMultiprocessorCount, dev);
        (void)hipFuncSetAttribute((const void*)fwd_kernel, hipFuncAttributeMaxDynamicSharedMemorySize, LDS_BYTES);
        if (hipOccupancyMaxActiveBlocksPerMultiprocessor(&per_cu, (const void*)fwd_kernel, NTHREADS, LDS_BYTES) != hipSuccess || per_cu < 1) per_cu = 1;
        (void)hipGetLastError();
        grid = cus * per_cu;
        if (ws_size < 512 * MiB) fprintf(stderr, "kernel_launch: workspace %zu < 512 MiB\n", ws_size);
    }
    (void)hipMemsetAsync((char*)d_ws + WS_BAR, 0, XCD_BAR_WORDS * 4, stream);
    Params p{};
    for (int i = 0; i < 32; ++i) p.in[i] = (const float*)d_in[i];
    p.out = (float*)d_out; p.ws = (unsigned char*)d_ws;
    void* args[] = {&p};
    hipError_t e = hipLaunchCooperativeKernel((const void*)fwd_kernel, dim3(grid), dim3(NTHREADS), args, LDS_BYTES, stream);
    if (e != hipSuccess) fprintf(stderr, "cooperative launch failed: %s (grid %d)\n", hipGetErrorString(e), grid);
}
```
